# Optimizing an MI355X kernel written in HIP

```python
import math
import jax, jax.numpy as jnp
from jax import lax
import numpy as np

D_MODEL = 1024
BATCH = 4
SEQ = 4096
DEPTH = 4
DEC_BATCH = 8
DEC_SEQ = 2048
PAST_LEN = 128

N_MEM = 256
EPS = 1e-6
S5_WIDTH = D_MODEL // 2
S5_GROUP = 16
S5_GROUPS = S5_WIDTH // S5_GROUP
S5_STATE = 64
GLA_HEADS = 4
GLA_DV = (D_MODEL // 2) // GLA_HEADS
GLA_DK = GLA_DV // 2
GLA_RANK = 16
GLA_TAU = 16.0
GLA_CHUNK = 64
GLA_QK = GLA_HEADS * GLA_DK
GLA_V = GLA_HEADS * GLA_DV
EV_COLS = S5_WIDTH + 2 * GLA_QK + 2 * GLA_V + 2 * GLA_RANK
EV_SPLITS = (S5_WIDTH, S5_WIDTH + GLA_QK, S5_WIDTH + 2 * GLA_QK,
             S5_WIDTH + 2 * GLA_QK + GLA_V, S5_WIDTH + 2 * GLA_QK + 2 * GLA_V)
DIFF_HEADS = 8
DIFF_DK = 64
DIFF_DV = 2 * DIFF_DK
Q_BLOCK = 128
X_HEADS = 4
X_DH = D_MODEL // X_HEADS
D_FF = 4 * D_MODEL
N_EVEN = (DEPTH + 1) // 2
N_ODD = DEPTH // 2

kernel_name = "hybrid_s5_gla_diffattn_encoder"


def rms_norm(x, g):
    xf = x.astype(jnp.float32)
    y = xf * lax.rsqrt(jnp.mean(xf * xf, axis=-1, keepdims=True) + EPS)
    return (y * g.astype(jnp.float32)).astype(x.dtype)


def alibi_slopes(n_heads):
    return jnp.asarray(2.0 ** (-8.0 * np.arange(1, n_heads + 1, dtype=np.float32) / n_heads), jnp.float32)


def s5_direction(u, lam_re, lam_im, log_step, b_re, b_im, c_re, c_im, reverse):
    f32 = jnp.float32
    lam = lax.complex(lam_re.astype(f32), lam_im.astype(f32))
    step = jnp.exp(log_step.astype(f32))[:, None]
    lam_bar = jnp.exp(lam * step)
    b = lax.complex(b_re.astype(f32), b_im.astype(f32))
    b_bar = ((lam_bar - 1.0) / lam)[..., None] * b
    c = lax.complex(c_re.astype(f32), c_im.astype(f32))
    bu = jnp.einsum('gpc,blgc->blgp', b_bar, u.astype(jnp.complex64))
    a = jnp.broadcast_to(lam_bar, bu.shape)

    def combine(left, right):
        a_l, b_l = left
        a_r, b_r = right
        return a_r * a_l, a_r * b_l + b_r

    _, states = lax.associative_scan(combine, (a, bu), axis=1, reverse=reverse)
    return jnp.einsum('gcp,blgp->blgc', c, states).real


def s5_mixer(u, lam_re, lam_im, log_step, b_re, b_im, c_re, c_im, d, w_glu):
    bsz, L, _ = u.shape
    ug = u.astype(jnp.float32).reshape(bsz, L, S5_GROUPS, S5_GROUP)
    y = (s5_direction(ug, lam_re[0], lam_im[0], log_step[0], b_re[0], b_im[0], c_re[0], c_im[0], False)
         + s5_direction(ug, lam_re[1], lam_im[1], log_step[1], b_re[1], b_im[1], c_re[1], c_im[1], True)
         + d.astype(jnp.float32) * ug)
    y = jax.nn.gelu(y.reshape(bsz, L, S5_WIDTH))
    y = y * jax.nn.sigmoid(y @ w_glu.astype(jnp.float32))
    return y.astype(u.dtype)


def gla_direction(q, k, v, g):
    bsz, L, H, dk = q.shape
    dv = v.shape[-1]
    C = GLA_CHUNK
    n = L // C
    q = q.reshape(bsz, n, C, H, dk)
    k = k.reshape(bsz, n, C, H, dk)
    v = v.reshape(bsz, n, C, H, dv)
    bcum = jnp.cumsum(g.reshape(bsz, n, C, H, dk), axis=2)
    blast = bcum[:, :, -1:]
    bref = bcum[:, :, C // 2 - 1:C // 2]
    q_rel = q * jnp.exp(bcum - bref)
    k_rel = k * jnp.exp(bref - bcum)
    scores = jnp.einsum('bnihd,bnjhd->bnhij', q_rel, k_rel)
    causal_in_chunk = jnp.tril(jnp.ones((C, C), dtype=bool))
    scores = jnp.where(causal_in_chunk, scores, 0.0)
    o_intra = jnp.einsum('bnhij,bnjhe->bnihe', scores, v)
    k_out = k * jnp.exp(blast - bcum)
    chunk_kv = jnp.einsum('bnjhd,bnjhe->bnhde', k_out, v)
    decay = jnp.exp(blast[:, :, 0])

    def step(S, inp):
        dec, kv = inp
        return dec[..., None] * S + kv, S

    S0 = jnp.zeros((bsz, H, dk, dv), jnp.float32)
    _, S_prev = lax.scan(step, S0, (jnp.moveaxis(decay, 1, 0), jnp.moveaxis(chunk_kv, 1, 0)))
    S_prev = jnp.moveaxis(S_prev, 0, 1)
    o_inter = jnp.einsum('bnihd,bnhde->bnihe', q * jnp.exp(bcum), S_prev)
    return (o_intra + o_inter).reshape(bsz, L, H, dv)


def gla_mixer(q, k, v, og, glr, w_gate, b_gate, norm_g):
    f32 = jnp.float32
    bsz, L, _ = q.shape
    qh = q.astype(f32).reshape(bsz, L, GLA_HEADS, GLA_DK) * (GLA_DK ** -0.5)
    kh = k.astype(f32).reshape(bsz, L, GLA_HEADS, GLA_DK)
    vh = v.astype(f32).reshape(bsz, L, GLA_HEADS, GLA_DV)
    lr = glr.astype(f32).reshape(bsz, L, 2, GLA_RANK)
    logit = jnp.einsum('blzr,zrk->blzk', lr, w_gate.astype(f32)) + b_gate.astype(f32)
    g = (jax.nn.log_sigmoid(logit) / GLA_TAU).reshape(bsz, L, 2, GLA_HEADS, GLA_DK)
    flip = lambda t: jnp.flip(t, axis=1)
    o = (gla_direction(qh, kh, vh, g[:, :, 0])
         + flip(gla_direction(flip(qh), flip(kh), flip(vh), flip(g[:, :, 1]))))
    o = rms_norm(o, norm_g).reshape(bsz, L, GLA_V)
    return (o * jax.nn.silu(og.astype(f32))).astype(q.dtype)


def diff_attention(h, w_in, q_norm, k_norm, lq1, lk1, lq2, lk2, sub_norm, lambda_init):
    f32 = jnp.float32
    bsz, L, _ = h.shape
    proj = (h @ w_in).astype(f32)
    q, k, v = jnp.split(proj, 3, axis=-1)
    q = rms_norm(q.reshape(bsz, L, DIFF_HEADS, 2, DIFF_DK), q_norm) * (DIFF_DK ** -0.5)
    k = rms_norm(k.reshape(bsz, L, DIFF_HEADS, 2, DIFF_DK), k_norm)
    v = v.reshape(bsz, L, DIFF_HEADS, DIFF_DV)
    lam = (jnp.exp(jnp.sum(lq1.astype(f32) * lk1.astype(f32)))
           - jnp.exp(jnp.sum(lq2.astype(f32) * lk2.astype(f32))) + lambda_init)
    slopes = alibi_slopes(DIFF_HEADS)[:, None, None]
    nblk = L // Q_BLOCK
    qb = jnp.moveaxis(q.reshape(bsz, nblk, Q_BLOCK, DIFF_HEADS, 2, DIFF_DK), 1, 0)
    kpos = jnp.arange(L, dtype=f32)

    def block(args):
        qblk, i = args
        qpos = (i * Q_BLOCK + jnp.arange(Q_BLOCK)).astype(f32)
        bias = -slopes * jnp.abs(qpos[:, None] - kpos[None, :])
        s = jnp.einsum('bqhzd,bkhzd->bzhqk', qblk, k) + bias[None, None]
        p = jax.nn.softmax(s, axis=-1)
        attn = p[:, 0] - lam * p[:, 1]
        return jnp.einsum('bhqk,bkhe->bqhe', attn, v)

    o = lax.map(block, (qb, jnp.arange(nblk)))
    o = jnp.moveaxis(o, 0, 1).reshape(bsz, L, DIFF_HEADS, DIFF_DV)
    o = rms_norm(o, sub_norm) * (1.0 - lambda_init)
    return o.reshape(bsz, L, DIFF_HEADS * DIFF_DV).astype(h.dtype)


def cross_attention(h, m, w_q, w_kv, w_o, q_norm, k_norm):
    f32 = jnp.float32
    bsz, L, _ = h.shape
    q = rms_norm((h @ w_q).astype(f32).reshape(bsz, L, X_HEADS, X_DH), q_norm) * (X_DH ** -0.5)
    kv = (m @ w_kv).astype(f32).reshape(bsz, m.shape[1], 2, X_HEADS, X_DH)
    k = rms_norm(kv[:, :, 0], k_norm)
    v = kv[:, :, 1]
    p = jax.nn.softmax(jnp.einsum('bqhd,bmhd->bhqm', q, k), axis=-1)
    o = jnp.einsum('bhqm,bmhd->bqhd', p, v).reshape(bsz, L, D_MODEL)
    return o.astype(h.dtype) @ w_o


def trunk(x, mem, p):
    for layer in range(DEPTH):
        h = rms_norm(x, p['norm_mix'][layer])
        if layer % 2 == 0:
            e = layer // 2
            proj = h @ p['ev_w_in'][e]
            u, q, k, v, og, glr = jnp.split(proj, EV_SPLITS, axis=-1)
            y_s5 = s5_mixer(u, p['s5_lambda_re'][e], p['s5_lambda_im'][e], p['s5_log_step'][e],
                            p['s5_b_re'][e], p['s5_b_im'][e], p['s5_c_re'][e], p['s5_c_im'][e],
                            p['s5_d'][e], p['s5_w_glu'][e])
            y_gla = gla_mixer(q, k, v, og, glr, p['gla_w_gate'][e], p['gla_b_gate'][e], p['gla_norm'][e])
            y = jnp.concatenate([y_s5, y_gla], axis=-1).astype(x.dtype) @ p['ev_w_out'][e]
        else:
            o = layer // 2
            lambda_init = 0.8 - 0.6 * math.exp(-0.3 * layer)
            y = diff_attention(h, p['od_w_in'][o], p['diff_q_norm'][o], p['diff_k_norm'][o],
                               p['diff_lambda_q1'][o], p['diff_lambda_k1'][o],
                               p['diff_lambda_q2'][o], p['diff_lambda_k2'][o],
                               p['diff_norm'][o], lambda_init) @ p['od_w_out'][o]
        x = x + y.astype(x.dtype)
        h = rms_norm(x, p['norm_cross'][layer])
        m = rms_norm(mem, p['norm_mem'][layer])
        x = x + cross_attention(h, m, p['x_w_q'][layer], p['x_w_kv'][layer], p['x_w_o'][layer],
                                p['x_q_norm'][layer], p['x_k_norm'][layer]).astype(x.dtype)
        h = rms_norm(x, p['norm_mlp'][layer])
        x = x + (jnp.square(jax.nn.relu(h @ p['mlp_w1'][layer])) @ p['mlp_w2'][layer]).astype(x.dtype)
    return x


def setup_inputs(seed: int = 0) -> dict:
    key = jax.random.key(seed)
    ks = iter(jax.random.split(key, 64))
    f32 = jnp.float32
    nrm = lambda shape, scale: scale * jax.random.normal(next(ks), shape, f32)
    gain = lambda shape: 1.0 + 0.02 * jax.random.normal(next(ks), shape, f32)
    E, O, G, P = N_EVEN, N_ODD, S5_GROUPS, S5_STATE
    n_idx = jnp.arange(P, dtype=f32)
    return {
        'x_prompt': nrm((BATCH, SEQ, D_MODEL), 1.0),
        'x_sample': nrm((DEC_BATCH, DEC_SEQ, D_MODEL), 1.0),
        'mem_prompt': nrm((BATCH, N_MEM, D_MODEL), 1.0),
        'mem_sample': nrm((DEC_BATCH, N_MEM, D_MODEL), 1.0),
        'norm_mix': gain((DEPTH, D_MODEL)),
        'norm_cross': gain((DEPTH, D_MODEL)),
        'norm_mem': gain((DEPTH, D_MODEL)),
        'norm_mlp': gain((DEPTH, D_MODEL)),
        'ev_w_in': nrm((E, D_MODEL, EV_COLS), D_MODEL ** -0.5),
        'ev_w_out': nrm((E, D_MODEL, D_MODEL), D_MODEL ** -0.5),
        's5_lambda_re': -0.5 + nrm((E, 2, G, P), 0.01),
        's5_lambda_im': math.pi * n_idx + nrm((E, 2, G, P), 0.01),
        's5_log_step': jax.random.uniform(next(ks), (E, 2, G), f32, math.log(1e-3), math.log(1e-1)),
        's5_b_re': nrm((E, 2, G, P, S5_GROUP), (2.0 * S5_GROUP) ** -0.5),
        's5_b_im': nrm((E, 2, G, P, S5_GROUP), (2.0 * S5_GROUP) ** -0.5),
        's5_c_re': nrm((E, 2, G, S5_GROUP, P), (2.0 * P) ** -0.5),
        's5_c_im': nrm((E, 2, G, S5_GROUP, P), (2.0 * P) ** -0.5),
        's5_d': nrm((E, G, S5_GROUP), 1.0),
        's5_w_glu': nrm((E, S5_WIDTH, S5_WIDTH), S5_WIDTH ** -0.5),
        'gla_w_gate': nrm((E, 2, GLA_RANK, GLA_QK), GLA_RANK ** -0.5),
        'gla_b_gate': nrm((E, 2, GLA_QK), 0.1),
        'gla_norm': gain((E, GLA_DV)),
        'od_w_in': nrm((O, D_MODEL, 3 * D_MODEL), D_MODEL ** -0.5),
        'od_w_out': nrm((O, D_MODEL, D_MODEL), D_MODEL ** -0.5),
        'diff_q_norm': gain((O, DIFF_DK)),
        'diff_k_norm': gain((O, DIFF_DK)),
        'diff_lambda_q1': nrm((O, DIFF_DK), 0.1),
        'diff_lambda_k1': nrm((O, DIFF_DK), 0.1),
        'diff_lambda_q2': nrm((O, DIFF_DK), 0.1),
        'diff_lambda_k2': nrm((O, DIFF_DK), 0.1),
        'diff_norm': gain((O, DIFF_DV)),
        'x_w_q': nrm((DEPTH, D_MODEL, D_MODEL), D_MODEL ** -0.5),
        'x_w_kv': nrm((DEPTH, D_MODEL, 2 * D_MODEL), D_MODEL ** -0.5),
        'x_w_o': nrm((DEPTH, D_MODEL, D_MODEL), D_MODEL ** -0.5),
        'x_q_norm': gain((DEPTH, X_DH)),
        'x_k_norm': gain((DEPTH, X_DH)),
        'mlp_w1': nrm((DEPTH, D_MODEL, D_FF), D_MODEL ** -0.5),
        'mlp_w2': nrm((DEPTH, D_FF, D_MODEL), D_FF ** -0.5),
    }


def reference(x_prompt, x_sample, mem_prompt, mem_sample, norm_mix, norm_cross, norm_mem, norm_mlp,
              ev_w_in, ev_w_out, s5_lambda_re, s5_lambda_im, s5_log_step, s5_b_re, s5_b_im,
              s5_c_re, s5_c_im, s5_d, s5_w_glu, gla_w_gate, gla_b_gate, gla_norm,
              od_w_in, od_w_out, diff_q_norm, diff_k_norm, diff_lambda_q1, diff_lambda_k1,
              diff_lambda_q2, diff_lambda_k2, diff_norm, x_w_q, x_w_kv, x_w_o, x_q_norm, x_k_norm,
              mlp_w1, mlp_w2):
    params = dict(norm_mix=norm_mix, norm_cross=norm_cross, norm_mem=norm_mem, norm_mlp=norm_mlp,
                  ev_w_in=ev_w_in, ev_w_out=ev_w_out, s5_lambda_re=s5_lambda_re,
                  s5_lambda_im=s5_lambda_im, s5_log_step=s5_log_step, s5_b_re=s5_b_re, s5_b_im=s5_b_im,
                  s5_c_re=s5_c_re, s5_c_im=s5_c_im, s5_d=s5_d, s5_w_glu=s5_w_glu,
                  gla_w_gate=gla_w_gate, gla_b_gate=gla_b_gate, gla_norm=gla_norm,
                  od_w_in=od_w_in, od_w_out=od_w_out, diff_q_norm=diff_q_norm, diff_k_norm=diff_k_norm,
                  diff_lambda_q1=diff_lambda_q1, diff_lambda_k1=diff_lambda_k1,
                  diff_lambda_q2=diff_lambda_q2, diff_lambda_k2=diff_lambda_k2, diff_norm=diff_norm,
                  x_w_q=x_w_q, x_w_kv=x_w_kv, x_w_o=x_w_o, x_q_norm=x_q_norm, x_k_norm=x_k_norm,
                  mlp_w1=mlp_w1, mlp_w2=mlp_w2)
    y_prompt = trunk(x_prompt, mem_prompt, params)
    y_sample = trunk(x_sample, mem_sample, params)
    return (y_prompt, y_sample)
```

```cpp
#include <hip/hip_runtime.h>
#include <hip/hip_cooperative_groups.h>
#include <cstdio>
#include <cstdint>
namespace cg = cooperative_groups;
#ifndef PROBE
#define PROBE 0
#endif
__device__ __forceinline__ int otid() { int t = threadIdx.x; asm volatile("" : "+v"(t)); return t; }
__device__ __forceinline__ int obid() { int b = blockIdx.x; asm volatile("" : "+s"(b)); return b; }
namespace pg8 {
#define PG8_LAS __attribute__((address_space(3)))
typedef unsigned short bf16_t;
typedef short bf16x8 __attribute__((ext_vector_type(8)));
typedef float f32x4 __attribute__((ext_vector_type(4)));
typedef unsigned u32x4 __attribute__((ext_vector_type(4)));
constexpr int BM = 256, BK = 64, HALF = 128, HTB = HALF * BK * 2  , STAGE_BYTES = 8 * HTB, NXCD = 8, WGM = 8;

__host__ __device__ __forceinline__ int lds_byte(int r, int c) { const int st = (r >> 4) * 2 + (c >> 5), rr = r & 15, cc = c & 31, ob = rr * 64 + cc * 2; return st * 1024 + (ob ^ (((ob >> 9) & 1) << 5)); }
__host__ __device__ __forceinline__ void stage_rc(int b, int& R, int& C) { const int st = b / 1024, sb = b % 1024, swz = sb ^ (((sb >> 9) & 1) << 5); R = (st >> 1) * 16 + swz / 64; C = (st & 1) * 32 + (swz % 64) / 2; }
__host__ __device__ __forceinline__ int perm32(int rho) { const int n = rho >> 4, i = rho & 15; return 8 * (i >> 2) + 4 * n + (i & 3); }

struct Unit { int pm, pn; };
struct Gemm { const bf16_t* A; int lda; const bf16_t* Bt; int M, N, K; };

struct StaticOrder {
    int nM, nN, nwg, G, c;
    __host__ __device__ void init(int M, int N, int G_, int c_) { nM = M / BM; nN = N / BM; nwg = nM * nN; G = G_; c = c_; }
    __host__ __device__ bool next(int i, Unit& u) const {
        const long L = (long)i * G + c; if (L >= nwg) return false;
        int wgid = (int)L; { const int q = nwg / NXCD, r = nwg % NXCD, xcd = wgid % NXCD, off = wgid / NXCD; wgid = (xcd < r ? xcd * (q + 1) : r * (q + 1) + (xcd - r) * q) + off; }
        const int nig = WGM * nN, gid = wgid / nig, fm = gid * WGM, gsz = (nM - fm) < WGM ? (nM - fm) : WGM;
        u.pm = fm + ((wgid % nig) % gsz); u.pn = (wgid % nig) / gsz; return true;
    }
    __device__ __forceinline__ void a_ready(const Unit&) const {}
    __device__ __forceinline__ void done(const Unit&) const {}
};

__device__ __forceinline__ unsigned cvt_pk_bf16(float lo, float hi) { unsigned r; asm volatile("v_cvt_pk_bf16_f32 %0, %1, %2" : "=v"(r) : "v"(lo), "v"(hi)); return r; }
typedef float f32x2 __attribute__((ext_vector_type(2)));
typedef float f32x2e __attribute__((ext_vector_type(2)));
typedef __bf16 bf16x2e __attribute__((ext_vector_type(2)));
__device__ __forceinline__ unsigned pk2e(float lo, float hi) { f32x2e v = {lo, hi}; bf16x2e b = __builtin_convertvector(v, bf16x2e); return __builtin_bit_cast(unsigned, b); }
template <int ACT  , bool RS = false  > struct EpiB {
    static constexpr bool PERM = true, AFTER_DRAIN = false;
    bf16_t* O; int ldc; const float* rsq;
    __device__ __forceinline__ void operator()(const f32x4 (&acc)[2][2][4][2], const Unit& u, int wr, int wc, int fr, int fq) const {
        const int row0 = u.pm * BM + wr * 64 + fr, col0 = u.pn * BM + wc * 32 + 8 * fq;
#pragma unroll
        for (int ai = 0; ai < 2; ++ai)
#pragma unroll
            for (int m = 0; m < 4; ++m) { bf16_t* rowp = O + (size_t)(row0 + ai * HALF + m * 16) * ldc + col0;
                float rstd = 1.f; if (RS) { const f32x4 r0 = *((const f32x4*)(rsq + (size_t)(row0 + ai * HALF + m * 16) * 16) + fq); float tot = (r0[0] + r0[1]) + (r0[2] + r0[3]); tot += __shfl_xor(tot, 16); tot += __shfl_xor(tot, 32); rstd = 1.f / sqrtf(tot * (1.f / 1024.f) + 1e-6f); }
#pragma unroll
                for (int bj = 0; bj < 2; ++bj) { f32x4 v0 = acc[ai][bj][m][0], v1 = acc[ai][bj][m][1];
                    if (RS) { v0 = v0 * rstd; v1 = v1 * rstd; }
                    if (ACT == 1) {
#pragma unroll
                        for (int q = 0; q < 4; ++q) { float a = v0[q] > 0.f ? v0[q] : 0.f; v0[q] = a * a; float b = v1[q] > 0.f ? v1[q] : 0.f; v1[q] = b * b; } }
                    u32x4 w; w.x = pk2e(v0[0], v0[1]); w.y = pk2e(v0[2], v0[3]); w.z = pk2e(v1[0], v1[1]); w.w = pk2e(v1[2], v1[3]);
                    *(u32x4*)(rowp + bj * HALF) = w; } }
    }
};
struct EpiRes {
    static constexpr bool PERM = false, AFTER_DRAIN = false;
    float* X; int ldc;
    __device__ __forceinline__ void operator()(const f32x4 (&acc)[2][2][4][2], const Unit& u, int wr, int wc, int fr, int fq) const {
        const int row0 = u.pm * BM + wr * 64 + fr, col0 = u.pn * BM + wc * 32 + 4 * fq;
#pragma unroll
        for (int ai = 0; ai < 2; ++ai)
#pragma unroll
            for (int m = 0; m < 4; ++m) { float* rowp = X + (size_t)(row0 + ai * HALF + m * 16) * ldc + col0;
#pragma unroll
                for (int bj = 0; bj < 2; ++bj)
#pragma unroll
                    for (int n = 0; n < 2; ++n) { f32x4* p = (f32x4*)(rowp + bj * HALF + n * 16); const f32x4 b = *p; *p = b + acc[ai][bj][m][n]; } }
    }
};
template <bool LAST> struct EpiRes3 {
    static constexpr bool PERM = true, AFTER_DRAIN = false;
    bf16_t* R; float* rsq; float* out;
    __device__ __forceinline__ void operator()(const f32x4 (&acc)[2][2][4][2], const Unit& u, int wr, int wc, int fr, int fq) const {
        const int row0 = u.pm * BM + wr * 64 + fr, col0 = u.pn * BM + wc * 32 + 8 * fq;
#pragma unroll
        for (int ai = 0; ai < 2; ++ai)
#pragma unroll
            for (int m = 0; m < 4; ++m) { const size_t row = (size_t)(row0 + ai * HALF + m * 16); bf16_t* bp = R + row * 1024 + col0; float ss = 0.f;
#pragma unroll
                for (int bj = 0; bj < 2; ++bj) { const u32x4 rv = *(const u32x4*)(bp + bj * HALF);
                    f32x4 v0, v1; v0[0] = __uint_as_float(rv.x << 16); v0[1] = __uint_as_float(rv.x & 0xffff0000u); v0[2] = __uint_as_float(rv.y << 16); v0[3] = __uint_as_float(rv.y & 0xffff0000u);
                    v1[0] = __uint_as_float(rv.z << 16); v1[1] = __uint_as_float(rv.z & 0xffff0000u); v1[2] = __uint_as_float(rv.w << 16); v1[3] = __uint_as_float(rv.w & 0xffff0000u);
                    v0 = v0 + acc[ai][bj][m][0]; v1 = v1 + acc[ai][bj][m][1];
                    if (LAST) { f32x4* p = (f32x4*)(out + row * 1024 + col0 + bj * HALF); p[0] = v0; p[1] = v1; }
                    else { u32x4 w; w.x = pk2e(v0[0], v0[1]); w.y = pk2e(v0[2], v0[3]); w.z = pk2e(v1[0], v1[1]); w.w = pk2e(v1[2], v1[3]); *(u32x4*)(bp + bj * HALF) = w;
                        const float a0 = __uint_as_float(w.x << 16), a1 = __uint_as_float(w.x & 0xffff0000u), a2 = __uint_as_float(w.y << 16), a3 = __uint_as_float(w.y & 0xffff0000u);
                        const float a4 = __uint_as_float(w.z << 16), a5 = __uint_as_float(w.z & 0xffff0000u), a6 = __uint_as_float(w.w << 16), a7 = __uint_as_float(w.w & 0xffff0000u);
                        ss += ((a0 * a0 + a1 * a1) + (a2 * a2 + a3 * a3)) + ((a4 * a4 + a5 * a5) + (a6 * a6 + a7 * a7)); } }
                if (!LAST) { ss += __shfl_xor(ss, 16); ss += __shfl_xor(ss, 32); if (fq == 0) rsq[row * 16 + u.pn * 4 + wc] = ss; } }
    }
};
struct EpiQKV {
    static constexpr bool PERM = true, AFTER_DRAIN = false;
    bf16_t* O; const float* rsq; const float* gq; const float* gk; float qscale;
    __device__ __forceinline__ void operator()(const f32x4 (&acc)[2][2][4][2], const Unit& u, int wr, int wc, int fr, int fq) const {
        const int row0 = u.pm * BM + wr * 64 + fr; const bool isqk = u.pn < 8;
        const float* g = u.pn < 4 ? gq : gk; const float sc = u.pn < 4 ? qscale : 1.f;
        f32x4 gv[2][2];
#pragma unroll
        for (int bj = 0; bj < 2; ++bj) { gv[bj][0] = *(const f32x4*)(g + 32 * bj + 8 * fq); gv[bj][1] = *(const f32x4*)(g + 32 * bj + 8 * fq + 4); }
#pragma unroll
        for (int ai = 0; ai < 2; ++ai)
#pragma unroll
            for (int m = 0; m < 4; ++m) { const size_t row = (size_t)(row0 + ai * HALF + m * 16);
                const f32x4 r0 = *((const f32x4*)(rsq + row * 16) + fq); float tot = (r0[0] + r0[1]) + (r0[2] + r0[3]); tot += __shfl_xor(tot, 16); tot += __shfl_xor(tot, 32);
                const float rstd = 1.f / sqrtf(tot * (1.f / 1024.f) + 1e-6f);
                f32x4 v[2][2]; float ss = 0.f;
#pragma unroll
                for (int bj = 0; bj < 2; ++bj)
#pragma unroll
                    for (int n = 0; n < 2; ++n) { v[bj][n] = acc[ai][bj][m][n] * rstd; ss += (v[bj][n][0] * v[bj][n][0] + v[bj][n][1] * v[bj][n][1]) + (v[bj][n][2] * v[bj][n][2] + v[bj][n][3] * v[bj][n][3]); }
                ss += __shfl_xor(ss, 16); ss += __shfl_xor(ss, 32);
                const float rg = isqk ? sc / sqrtf(ss * (1.f / 64.f) + 1e-6f) : 1.f;
#pragma unroll
                for (int bj = 0; bj < 2; ++bj) { f32x4 v0 = v[bj][0], v1 = v[bj][1];
                    if (isqk) { v0 = v0 * gv[bj][0] * rg; v1 = v1 * gv[bj][1] * rg; }
                    u32x4 w; w.x = pk2e(v0[0], v0[1]); w.y = pk2e(v0[2], v0[3]); w.z = pk2e(v1[0], v1[1]); w.w = pk2e(v1[2], v1[3]);
                    const int col = isqk ? (u.pn * BM + 64 * wc + 32 * bj + 8 * fq) : (u.pn * BM + bj * HALF + wc * 32 + 8 * fq);
                    *(u32x4*)(O + row * 3072 + col) = w; } }
    }
};
struct EpiGlu {
    static constexpr bool PERM = true, AFTER_DRAIN = false;
    const bf16_t* Y; int ldy; bf16_t* O; int ldc;
    __device__ __forceinline__ void operator()(const f32x4 (&acc)[2][2][4][2], const Unit& u, int wr, int wc, int fr, int fq) const {
        const int row0 = u.pm * BM + wr * 64 + fr, col0 = u.pn * BM + wc * 32 + 8 * fq;
#pragma unroll
        for (int ai = 0; ai < 2; ++ai)
#pragma unroll
            for (int m = 0; m < 4; ++m) { const size_t row = (size_t)(row0 + ai * HALF + m * 16);
#pragma unroll
                for (int bj = 0; bj < 2; ++bj) { const f32x4 v0 = acc[ai][bj][m][0], v1 = acc[ai][bj][m][1];
                    const u32x4 yv = *(const u32x4*)(Y + row * ldy + col0 + bj * HALF);
                    float y[8]; y[0] = __uint_as_float(yv.x << 16); y[1] = __uint_as_float(yv.x & 0xffff0000u); y[2] = __uint_as_float(yv.y << 16); y[3] = __uint_as_float(yv.y & 0xffff0000u);
                    y[4] = __uint_as_float(yv.z << 16); y[5] = __uint_as_float(yv.z & 0xffff0000u); y[6] = __uint_as_float(yv.w << 16); y[7] = __uint_as_float(yv.w & 0xffff0000u);
                    float o[8];
#pragma unroll
                    for (int q = 0; q < 4; ++q) { o[q] = y[q] / (1.f + __expf(-v0[q])); o[4 + q] = y[4 + q] / (1.f + __expf(-v1[q])); }
                    u32x4 w; w.x = pk2e(o[0], o[1]); w.y = pk2e(o[2], o[3]); w.z = pk2e(o[4], o[5]); w.w = pk2e(o[6], o[7]);
                    *(u32x4*)(O + row * ldc + col0 + bj * HALF) = w; } }
    }
};
template <class Epi, class Sched, bool ALIGN_EPI = false, bool SP2 = false>
__device__ __forceinline__ void gemm_phase(PG8_LAS unsigned char* lds, const Gemm g, const Sched& S, const Epi& E) {
    const int tid = otid(), wid = __builtin_amdgcn_readfirstlane(tid >> 6), lane = tid & 63, wr = wid >> 2, wc = wid & 3, fr = lane & 15, fq = lane >> 4;
    const int K = g.K, nt = K / BK;
    unsigned voffA[2], voffB[2];
#pragma unroll
    for (int i = 0; i < 2; ++i) { int R, C; stage_rc(tid * 16 + i * 8192, R, C); const int Rb = Epi::PERM ? ((R & ~31) + perm32(R & 31)) : R;
        voffA[i] = (unsigned)(R * g.lda + C) * 2u; voffB[i] = (unsigned)(Rb * K + C) * 2u; }
    const size_t kstep = (size_t)(BK * 2);
    const size_t hstep = (size_t)HALF * K * 2;
    const size_t tstep = 2 * hstep;
    const size_t hstepA = (size_t)HALF * g.lda * 2, tstepA = 2 * hstepA;
    const unsigned ldsw = (unsigned)wid * 1024u;
    const int aoff = lds_byte(wr * 64 + fr, fq * 8), boff = lds_byte(wc * 32 + fr, fq * 8);
#define PG8_SA(b, h) (((b) * 2 + (h)) * HTB)
#define PG8_SB(b, h) ((4 + (b) * 2 + (h)) * HTB)
#define PG8_STAGE(bufoff, gbase, voff) do { _Pragma("unroll") for (int _i = 0; _i < 2; ++_i) \
        __builtin_amdgcn_global_load_lds((const unsigned*)((const char*)(gbase) + (voff)[_i]), (PG8_LAS unsigned*)(lds + (bufoff) + ldsw + _i * 8192), 16, 0, 0); } while (0)
#define PG8_LDA(dst, b, h) do { _Pragma("unroll") for (int m = 0; m < 4; ++m) _Pragma("unroll") for (int k = 0; k < 2; ++k) dst[m][k] = *(const PG8_LAS bf16x8*)(lds + PG8_SA(b, h) + aoff + m * 2048 + k * 1024); } while (0)
#define PG8_LDB(dst, b, h) do { _Pragma("unroll") for (int n = 0; n < 2; ++n) _Pragma("unroll") for (int k = 0; k < 2; ++k) dst[n][k] = *(const PG8_LAS bf16x8*)(lds + PG8_SB(b, h) + boff + n * 2048 + k * 1024); } while (0)
#define PG8_MMA(ai, bj, At, Bt) do { __builtin_amdgcn_s_setprio(1); _Pragma("unroll") for (int m = 0; m < 4; ++m) _Pragma("unroll") for (int n = 0; n < 2; ++n) _Pragma("unroll") for (int k = 0; k < 2; ++k) \
        acc[ai][bj][m][n] = __builtin_amdgcn_mfma_f32_16x16x32_bf16(Bt[n][k], At[m][k], acc[ai][bj][m][n], 0, 0, 0); __builtin_amdgcn_s_setprio(0); } while (0)
#define PG8_WAIT_V(n) asm volatile("s_waitcnt vmcnt(" #n ")" ::: "memory")
#define PG8_WAIT_L(n) asm volatile("s_waitcnt lgkmcnt(" #n ")" ::: "memory")
#define PG8_BAR __builtin_amdgcn_s_barrier()
#define PG8_SCHED __builtin_amdgcn_sched_barrier(0)
    Unit cur, nxt; int ui = 0;
    if (!S.next(0, cur)) return;
    f32x4 acc[2][2][4][2];
#pragma unroll
    for (int a = 0; a < 2; ++a)
#pragma unroll
        for (int b = 0; b < 2; ++b)
#pragma unroll
            for (int m = 0; m < 4; ++m)
#pragma unroll
                for (int n = 0; n < 2; ++n) acc[a][b][m][n] = (f32x4){0.f, 0.f, 0.f, 0.f};
    bf16x8 At[4][2], B0[2][2], B1[2][2];
    const char* cA = (const char*)g.A + (size_t)cur.pm * tstepA; const char* cB = (const char*)g.Bt + (size_t)cur.pn * tstep;
    S.a_ready(cur);
    if constexpr (SP2) {
        PG8_STAGE(PG8_SB(0, 0), cB, voffB); PG8_STAGE(PG8_SB(0, 1), cB + hstep, voffB); PG8_STAGE(PG8_SA(0, 0), cA, voffA); PG8_STAGE(PG8_SA(0, 1), cA + hstepA, voffA);
        if (wr == 1) PG8_BAR;
        PG8_WAIT_V(2); PG8_BAR;
        PG8_STAGE(PG8_SB(1, 0), cB + kstep, voffB); PG8_STAGE(PG8_SA(1, 0), cA + kstep, voffA); PG8_STAGE(PG8_SB(1, 1), cB + hstep + kstep, voffB);
        PG8_WAIT_V(6); PG8_BAR;
    } else {
        PG8_STAGE(PG8_SB(0, 0), cB, voffB); PG8_STAGE(PG8_SA(0, 0), cA, voffA); PG8_STAGE(PG8_SB(0, 1), cB + hstep, voffB); PG8_STAGE(PG8_SA(0, 1), cA + hstepA, voffA);
        if (wr == 1) PG8_BAR;
        PG8_WAIT_V(4); PG8_BAR;
        PG8_STAGE(PG8_SB(1, 0), cB + kstep, voffB); PG8_STAGE(PG8_SA(1, 0), cA + kstep, voffA); PG8_STAGE(PG8_SB(1, 1), cB + hstep + kstep, voffB);
        PG8_WAIT_V(6); PG8_BAR;
    }
    for (;;) {
        const bool has_next = S.next(ui + 1, nxt);
        const char* nA = has_next ? (const char*)g.A + (size_t)nxt.pm * tstepA : cA; const char* nB = has_next ? (const char*)g.Bt + (size_t)nxt.pn * tstep : cB;
        for (int t = 0; t < nt; t += 2) {
            const bool last = (t == nt - 2);
            const char* a1 = cA + (size_t)(t + 1) * kstep;
            const char* a2 = last ? nA : cA + (size_t)(t + 2) * kstep; const char* b2 = last ? nB : cB + (size_t)(t + 2) * kstep;
            const char* a3 = a2 + kstep; const char* b3 = b2 + kstep;
            if (last && has_next) S.a_ready(nxt);
            if constexpr (SP2) {
            PG8_LDB(B0, 0, 0); PG8_LDB(B1, 0, 1); PG8_SCHED; PG8_LDA(At, 0, 0); PG8_STAGE(PG8_SA(1, 1), a1 + hstepA, voffA);
            PG8_WAIT_V(8); PG8_WAIT_L(0); PG8_BAR; PG8_MMA(0, 0, At, B0); PG8_MMA(0, 1, At, B1); PG8_BAR; PG8_SCHED;
            PG8_LDA(At, 0, 1); PG8_STAGE(PG8_SB(0, 0), b2, voffB); PG8_STAGE(PG8_SB(0, 1), b2 + hstep, voffB); PG8_STAGE(PG8_SA(0, 0), a2, voffA);
            PG8_WAIT_V(8); PG8_WAIT_L(0); PG8_BAR; PG8_MMA(1, 0, At, B0); PG8_MMA(1, 1, At, B1); PG8_BAR; PG8_SCHED;
            PG8_LDB(B0, 1, 0); PG8_LDB(B1, 1, 1); PG8_SCHED; PG8_LDA(At, 1, 0); PG8_STAGE(PG8_SA(0, 1), a2 + hstepA, voffA);
            PG8_WAIT_V(8); PG8_WAIT_L(0); PG8_BAR; PG8_MMA(0, 0, At, B0); PG8_MMA(0, 1, At, B1); PG8_BAR; PG8_SCHED;
            PG8_LDA(At, 1, 1); PG8_STAGE(PG8_SB(1, 0), b3, voffB); PG8_STAGE(PG8_SB(1, 1), b3 + hstep, voffB); PG8_STAGE(PG8_SA(1, 0), a3, voffA);
            PG8_WAIT_V(8); PG8_WAIT_L(0); PG8_BAR; PG8_MMA(1, 0, At, B0); PG8_MMA(1, 1, At, B1); PG8_BAR; PG8_SCHED;
            } else {
            PG8_LDB(B0, 0, 0); PG8_SCHED; PG8_LDA(At, 0, 0); PG8_STAGE(PG8_SA(1, 1), a1 + hstepA, voffA);
            PG8_WAIT_L(8); PG8_BAR; PG8_WAIT_L(0); PG8_MMA(0, 0, At, B0); PG8_BAR; PG8_SCHED;
            PG8_LDB(B1, 0, 1); PG8_STAGE(PG8_SB(0, 0), b2, voffB);
            PG8_BAR; PG8_WAIT_L(0); PG8_MMA(0, 1, At, B1); PG8_BAR;
            PG8_LDA(At, 0, 1); PG8_STAGE(PG8_SA(0, 0), a2, voffA);
            PG8_BAR; PG8_WAIT_L(0); PG8_MMA(1, 0, At, B0); PG8_BAR; PG8_SCHED;
            PG8_STAGE(PG8_SB(0, 1), b2 + hstep, voffB);
            PG8_WAIT_V(6); PG8_BAR; PG8_MMA(1, 1, At, B1); PG8_BAR;
            PG8_LDB(B0, 1, 0); PG8_SCHED; PG8_LDA(At, 1, 0); PG8_STAGE(PG8_SA(0, 1), a2 + hstepA, voffA);
            PG8_WAIT_L(8); PG8_BAR; PG8_WAIT_L(0); PG8_MMA(0, 0, At, B0); PG8_BAR; PG8_SCHED;
            PG8_LDB(B1, 1, 1); PG8_STAGE(PG8_SB(1, 0), b3, voffB);
            PG8_BAR; PG8_WAIT_L(0); PG8_MMA(0, 1, At, B1); PG8_BAR;
            PG8_LDA(At, 1, 1); PG8_STAGE(PG8_SA(1, 0), a3, voffA);
            PG8_BAR; PG8_WAIT_L(0); PG8_MMA(1, 0, At, B0); PG8_BAR; PG8_SCHED;
            PG8_STAGE(PG8_SB(1, 1), b3 + hstep, voffB);
            PG8_WAIT_V(6); PG8_BAR; PG8_MMA(1, 1, At, B1); PG8_BAR;
            }
        }
        if constexpr (ALIGN_EPI) { if (wr == 0) PG8_BAR; }
        if constexpr (!Epi::AFTER_DRAIN) { E(acc, cur, wr, wc, fr, fq); S.done(cur); }
        if (!has_next) break;
#pragma unroll
        for (int a = 0; a < 2; ++a)
#pragma unroll
            for (int b = 0; b < 2; ++b)
#pragma unroll
                for (int m = 0; m < 4; ++m)
#pragma unroll
                    for (int n = 0; n < 2; ++n) acc[a][b][m][n] = (f32x4){0.f, 0.f, 0.f, 0.f};
        cur = nxt; cA = nA; cB = nB; ++ui;
        if constexpr (ALIGN_EPI) { if (wr == 1) PG8_BAR; }
    }
    PG8_WAIT_V(0);
    if constexpr (!ALIGN_EPI) { if (wr == 0) PG8_BAR; }
    PG8_BAR;
    if constexpr (Epi::AFTER_DRAIN) { E.fused(acc, cur, wr, wc, fr, fq, lds, wid, lane); S.done(cur); }
#undef PG8_SA
#undef PG8_SB
#undef PG8_STAGE
#undef PG8_LDA
#undef PG8_LDB
#undef PG8_MMA
#undef PG8_WAIT_V
#undef PG8_WAIT_L
#undef PG8_BAR
#undef PG8_SCHED
}
}
typedef unsigned short bf16;
typedef short bf16x8 __attribute__((ext_vector_type(8)));
typedef float f32x4 __attribute__((ext_vector_type(4)));
typedef float f32x16 __attribute__((ext_vector_type(16)));
typedef unsigned u32x4 __attribute__((ext_vector_type(4)));
typedef unsigned u32x2 __attribute__((ext_vector_type(2)));
#define DI __device__ __forceinline__
#define LDS_WAIT() asm volatile("s_waitcnt lgkmcnt(0)" ::: "memory")

constexpr int MTOK = 32768;
constexpr size_t MiB = 1u << 20;
constexpr size_t WS_W = 2 * MiB, WS_ROWSQ = 42 * MiB;
constexpr size_t W_IN = WS_W, W_OUT = WS_W + 6 * MiB, W_GLU = WS_W + 8 * MiB, W_XQ = WS_W + 9 * MiB, W_XKV = WS_W + 11 * MiB, W_XO = WS_W + 15 * MiB, W_1 = WS_W + 17 * MiB, W_2 = WS_W + 25 * MiB;
constexpr size_t WS_MN = 35 * MiB, WS_DEC = 41 * MiB, WS_HN = 48 * MiB, WS_BIG = 112 * MiB;
constexpr size_t WS_XBB = WS_BIG + 192 * MiB;
constexpr size_t WS_KV = WS_BIG + 144 * MiB;
constexpr size_t WS_KVX = WS_BIG + 64 * MiB;
constexpr size_t WS_END = WS_BIG + 256 * MiB;
constexpr int LDS_BYTES = 135168;
constexpr float LOG2E = 1.4426950408889634f;

struct KArgs { const float* in[38]; float* out; unsigned char* ws; };
__device__ __forceinline__ const KArgs* kargs() { auto p = __builtin_amdgcn_kernarg_segment_ptr(); asm volatile("" : "+s"(p)); return (const KArgs*)p; }


DI float wave_sum(float v) {
#pragma unroll
    for (int o = 1; o < 64; o <<= 1) v += __shfl_xor(v, o);
    return v;
}
DI float wave_max(float v) {
#pragma unroll
    for (int o = 1; o < 64; o <<= 1) v = fmaxf(v, __shfl_xor(v, o));
    return v;
}
DI unsigned pk2(float lo, float hi) { return pg8::pk2e(lo, hi); }
DI float bflo(unsigned w) { return __uint_as_float(w << 16); }
DI float bfhi(unsigned w) { return __uint_as_float(w & 0xffff0000u); }
DI bf16 f2b(float f) { return (bf16)(pk2(f, 0.f) & 0xffffu); }
DI void unpack8(const u32x4 v, float* f) { f[0] = bflo(v.x); f[1] = bfhi(v.x); f[2] = bflo(v.y); f[3] = bfhi(v.y); f[4] = bflo(v.z); f[5] = bfhi(v.z); f[6] = bflo(v.w); f[7] = bfhi(v.w); }
DI u32x4 pack8u(const float* f) { u32x4 o; o.x = pk2(f[0], f[1]); o.y = pk2(f[2], f[3]); o.z = pk2(f[4], f[5]); o.w = pk2(f[6], f[7]); return o; }
DI f32x16 mfma32(bf16x8 a, bf16x8 b, f32x16 c) { return __builtin_amdgcn_mfma_f32_32x32x16_bf16(a, b, c, 0, 0, 0); }
DI f32x4 mfma16(bf16x8 a, bf16x8 b, f32x4 c) { return __builtin_amdgcn_mfma_f32_16x16x32_bf16(a, b, c, 0, 0, 0); }
DI int crow(int r, int hi) { return (r & 3) + 8 * (r >> 2) + 4 * hi; }

DI void transpose_item(const float* W, int K, int N, bf16* WT, float* scr, int item, int lane, const float* gain = nullptr, int qkperm = 0) {
    const int nblk = N / 32, kb = item / nblk, nb = item % nblk, k0 = 64 * kb, n0 = 32 * nb;
#pragma unroll 8
    for (int i = 0; i < 32; ++i) { const int kk = 2 * i + (lane >> 5); scr[kk * 33 + (lane & 31)] = W[(size_t)(k0 + kk) * N + n0 + (lane & 31)]; }
    LDS_WAIT();
    const int c = lane & 7;
    f32x4 g0 = (f32x4){1.f, 1.f, 1.f, 1.f}, g1 = g0;
    if (gain) { g0 = *(const f32x4*)(gain + k0 + 8 * c); g1 = *(const f32x4*)(gain + k0 + 8 * c + 4); }
#pragma unroll
    for (int j = 0; j < 4; ++j) { const int n = (lane >> 3) + 8 * j; const float* s = scr + (8 * c) * 33 + n;
        u32x4 o; o.x = pk2(s[0 * 33] * g0[0], s[1 * 33] * g0[1]); o.y = pk2(s[2 * 33] * g0[2], s[3 * 33] * g0[3]); o.z = pk2(s[4 * 33] * g1[0], s[5 * 33] * g1[1]); o.w = pk2(s[6 * 33] * g1[2], s[7 * 33] * g1[3]);
        const int cc = n0 + n; const int prow = (qkperm && cc < 2048) ? ((cc & ~255) + 128 * ((cc >> 5) & 1) + 32 * ((cc >> 6) & 3) + (cc & 31)) : cc;
        *(u32x4*)(WT + (size_t)prow * K + k0 + 8 * c) = o; }
    LDS_WAIT();
}
DI void convert_weights(int layer, unsigned char* lds) {
    const KArgs& a = *kargs();
    const int tid = otid(), lane = tid & 63, wave = tid >> 6;
    const int gw = obid() * 8 + wave, NGW = gridDim.x * 8;
    float* scr = (float*)(lds + wave * 8448);
    unsigned char* ws = a.ws;
    const bool even = !(layer & 1); const int hi = layer >> 1;
    const int nIn = even ? 16 * 65 : 16 * 96, nOut = 512, nGlu = even ? 128 : 0, nXq = 512, nXkv = 1024, nXo = 512, n1 = 2048, n2 = 2048;
    const int total = nIn + nOut + nGlu + nXq + nXkv + nXo + n1 + n2;
    for (int it = gw; it < total; it += NGW) {
        int r = it;
        if (r < nIn) { if (even) transpose_item(a.in[8] + (size_t)hi * 1024 * 2080, 1024, 2080, (bf16*)(ws + W_IN), scr, r, lane, a.in[4] + layer * 1024);
                       else transpose_item(a.in[22] + (size_t)hi * 1024 * 3072, 1024, 3072, (bf16*)(ws + W_IN), scr, r, lane, a.in[4] + layer * 1024, 1); continue; } r -= nIn;
        if (r < nOut) { transpose_item((even ? a.in[9] : a.in[23]) + (size_t)hi * 1024 * 1024, 1024, 1024, (bf16*)(ws + W_OUT), scr, r, lane); continue; } r -= nOut;
        if (r < nGlu) { transpose_item(a.in[18] + (size_t)hi * 512 * 512, 512, 512, (bf16*)(ws + W_GLU), scr, r, lane); continue; } r -= nGlu;
        if (r < nXq) { transpose_item(a.in[31] + (size_t)layer * 1024 * 1024, 1024, 1024, (bf16*)(ws + W_XQ), scr, r, lane, a.in[5] + layer * 1024); continue; } r -= nXq;
        if (r < nXkv) { transpose_item(a.in[32] + (size_t)layer * 1024 * 2048, 1024, 2048, (bf16*)(ws + W_XKV), scr, r, lane); continue; } r -= nXkv;
        if (r < nXo) { transpose_item(a.in[33] + (size_t)layer * 1024 * 1024, 1024, 1024, (bf16*)(ws + W_XO), scr, r, lane); continue; } r -= nXo;
        if (r < n1) { transpose_item(a.in[36] + (size_t)layer * 1024 * 4096, 1024, 4096, (bf16*)(ws + W_1), scr, r, lane, a.in[7] + layer * 1024); continue; } r -= n1;
        transpose_item(a.in[37] + (size_t)layer * 4096 * 1024, 4096, 1024, (bf16*)(ws + W_2), scr, r, lane);
    }
    if (even) {
        u32x4* z = (u32x4*)(ws + W_IN + (size_t)2080 * 1024 * 2); const int n16 = 224 * 1024 * 2 / 16;
        for (int i = obid() * 512 + tid; i < n16; i += gridDim.x * 512) z[i] = (u32x4){0u, 0u, 0u, 0u};
    }
}
template <bool COPY> DI void norm_rows(const float* src0, const float* src1, int split, int nrows, const float* gain, bf16* out, float* copy_dst) {
    const int tid = otid(), lane = tid & 63, wave = tid >> 6;
    const int gw = obid() * 8 + wave, NGW = gridDim.x * 8;
    f32x4 g[4];
#pragma unroll
    for (int j = 0; j < 4; ++j) g[j] = ((const f32x4*)gain)[lane + 64 * j];
    for (int m = gw; m < nrows; m += NGW) {
        const float* xr = (m < split) ? src0 + (size_t)m * 1024 : src1 + (size_t)(m - split) * 1024;
        f32x4 v[4]; float s = 0.f;
#pragma unroll
        for (int j = 0; j < 4; ++j) { v[j] = ((const f32x4*)xr)[lane + 64 * j]; s += (v[j].x * v[j].x + v[j].y * v[j].y) + (v[j].z * v[j].z + v[j].w * v[j].w); }
        const float rstd = 1.f / sqrtf(wave_sum(s) * (1.f / 1024.f) + 1e-6f);
        u32x2* o8 = (u32x2*)(out + (size_t)m * 1024);
#pragma unroll
        for (int j = 0; j < 4; ++j) { u32x2 w; w.x = pk2(v[j].x * rstd * g[j].x, v[j].y * rstd * g[j].y); w.y = pk2(v[j].z * rstd * g[j].z, v[j].w * rstd * g[j].w); o8[lane + 64 * j] = w;
            if (COPY) ((f32x4*)(copy_dst + (size_t)m * 1024))[lane + 64 * j] = v[j]; }
    }
}
DI void prep_rows(const float* src0, const float* src1, bf16* R, float* rsq) {
    const int tid = otid(), lane = tid & 63, wave = tid >> 6;
    const int gw = obid() * 8 + wave, NGW = gridDim.x * 8;
    for (int m = gw; m < MTOK; m += NGW) {
        const float* xr = (m < 16384) ? src0 + (size_t)m * 1024 : src1 + (size_t)(m - 16384) * 1024;
        float s = 0.f; u32x2* o8 = (u32x2*)(R + (size_t)m * 1024);
#pragma unroll
        for (int j = 0; j < 4; ++j) { const f32x4 v = ((const f32x4*)xr)[lane + 64 * j]; u32x2 w; w.x = pk2(v.x, v.y); w.y = pk2(v.z, v.w); o8[lane + 64 * j] = w;
            const float a0 = bflo(w.x), a1 = bfhi(w.x), a2 = bflo(w.y), a3 = bfhi(w.y); s += (a0 * a0 + a1 * a1) + (a2 * a2 + a3 * a3); }
        s = wave_sum(s);
        if (lane < 16) rsq[(size_t)m * 16 + lane] = lane == 0 ? s : 0.f;
    }
}
DI void segnorm(bf16* buf, int ld, int rows, int nchunks, int W, const float* gainA, float scaleA, int chunksA, const float* gainB, float scaleB) {
    const int tid = otid(), lane = tid & 63, wave = tid >> 6;
    const int gw = obid() * 8 + wave, NGW = gridDim.x * 8;
    const int total = rows * nchunks, gi = (lane * 8) % W; const float invW = 1.f / (float)W; const int lim = W / 8;
    for (int it = gw; it < total; it += NGW) {
        const int row = it / nchunks, ch = it % nchunks;
        bf16* p = buf + (size_t)row * ld + ch * 512 + lane * 8;
        const u32x4 v = *(const u32x4*)p; float f[8]; unpack8(v, f);
        float s = 0.f;
#pragma unroll
        for (int i = 0; i < 8; ++i) s += f[i] * f[i];
        for (int o = 1; o < lim; o <<= 1) s += __shfl_xor(s, o);
        const float rstd = 1.f / sqrtf(s * invW + 1e-6f);
        const float* g = (ch < chunksA) ? gainA : gainB; const float sc = ((ch < chunksA) ? scaleA : scaleB) * rstd;
#pragma unroll
        for (int i = 0; i < 8; ++i) f[i] = f[i] * sc * g[gi + i];
        *(u32x4*)p = pack8u(f);
    }
}
template <int M, int N, int K, int LDA, class Epi> DI void run_gemm(unsigned char* lds, const bf16* A, const bf16* Bt, const Epi& E) {
    constexpr int lda = LDA;
    pg8::Gemm g{A, lda, Bt, M, N, K}; pg8::StaticOrder S; S.init(M, N, (int)gridDim.x, obid());
    pg8::gemm_phase<Epi, pg8::StaticOrder, true, true>((PG8_LAS unsigned char*)lds, g, S, E);
}
#define S5_FENCE() asm volatile("" ::: "memory")
DI float fma_s(float a, float b, float c) { float d; asm("v_fma_f32 %0, %1, %2, %3" : "=v"(d) : "v"(a), "v"(b), "v"(c)); return d; }
DI void s5_phase(int e, unsigned char* lds, const bf16* proj, bf16* yf, bf16* yb) {
    const KArgs& a = *kargs();
    const int tid = otid(), lane = tid & 63, wave = tid >> 6, l31 = lane & 31, hi = lane >> 5; const int G = gridDim.x;
    float* BUf = (float*)(lds + wave * 27136); unsigned char* sb = lds + wave * 27136 + 18432;
    if (wave < 4) for (int t = wave * G + obid(); t < 768; t += 4 * G) {
        int seq, rem, L, rowbase;
        if (t < 256) { seq = t >> 6; rem = t & 63; L = 4096; rowbase = seq * 4096; }
        else { const int t2 = t - 256; seq = t2 >> 6; rem = t2 & 63; L = 2048; rowbase = 16384 + seq * 2048; }
        const int g = rem >> 1, dir = rem & 1;
        const int pd = (e * 2 + dir) * 32 + g;
        const float stp = expf(a.in[12][pd]);
        float lbr, lbi;
        { const float lr = a.in[10][pd * 64 + lane], li = a.in[11][pd * 64 + lane]; const float mag = expf(lr * stp); float sn, cs; sincosf(li * stp, &sn, &cs); lbr = mag * cs; lbi = mag * sn; }
        bf16x8 bfr[4];
#pragma unroll
        for (int nb = 0; nb < 4; ++nb) { const int col = 32 * nb + l31, p = col >> 1, ri = col & 1;
            const float lr = a.in[10][pd * 64 + p], li = a.in[11][pd * 64 + p]; const float mag = expf(lr * stp); float sn, cs; sincosf(li * stp, &sn, &cs);
            const float nr0 = mag * cs - 1.f, ni0 = mag * sn, den = lr * lr + li * li;
            const float cr = (nr0 * lr + ni0 * li) / den, ci = (ni0 * lr - nr0 * li) / den;
            const f32x4* br4 = (const f32x4*)(a.in[13] + ((size_t)pd * 64 + p) * 16 + 8 * hi); const f32x4* bi4 = (const f32x4*)(a.in[14] + ((size_t)pd * 64 + p) * 16 + 8 * hi);
            float f[8];
#pragma unroll
            for (int q = 0; q < 2; ++q) { const f32x4 x = br4[q], y = bi4[q];
#pragma unroll
                for (int i = 0; i < 4; ++i) f[4 * q + i] = ri ? (cr * y[i] + ci * x[i]) : (cr * x[i] - ci * y[i]); }
            bfr[nb] = __builtin_bit_cast(bf16x8, pack8u(f)); }
        bf16x8 cf[4];
        { const int c = lane & 15, kq = lane >> 4; const float* cre = a.in[15] + ((size_t)pd * 16 + c) * 64; const float* cim = a.in[16] + ((size_t)pd * 16 + c) * 64;
#pragma unroll
          for (int s = 0; s < 4; ++s) { float f[8];
#pragma unroll
              for (int j = 0; j < 4; ++j) { const int pp = 16 * s + 4 * kq + j; f[2 * j] = cre[pp]; f[2 * j + 1] = -cim[pp]; }
              cf[s] = __builtin_bit_cast(bf16x8, pack8u(f)); } }
        float sr = 0.f, si = 0.f; const float nlbi = -lbi;
        const int NC = L / 32;
        bf16* ydst = dir ? yb : yf;
        const bf16* ubase = proj + (size_t)(rowbase + l31) * 2304 + g * 16 + 8 * hi;
        bf16x8 ua = *(const bf16x8*)(ubase + (size_t)((dir ? NC - 1 : 0) * 32) * 2304);
        for (int ci2 = 0; ci2 < NC; ++ci2) {
            const int c = dir ? NC - 1 - ci2 : ci2; const int t0 = c * 32;
#pragma unroll
            for (int nb = 0; nb < 4; ++nb) { const f32x16 d = mfma32(ua, bfr[nb], f32x16{});
#pragma unroll
                for (int j = 0; j < 4; ++j) *(f32x4*)(BUf + (32 * nb + l31) * 36 + 8 * j + 4 * hi) = (f32x4){d[4 * j], d[4 * j + 1], d[4 * j + 2], d[4 * j + 3]}; }
            S5_FENCE();
            if (ci2 + 1 < NC) { const int cn = dir ? c - 1 : c + 1; ua = *(const bf16x8*)(ubase + (size_t)(cn * 32) * 2304); }
            typedef float f32x2s __attribute__((ext_vector_type(2)));
            f32x2s bu[32];
#pragma unroll
            for (int q = 0; q < 8; ++q) { const f32x4 re4 = *(const f32x4*)(BUf + (2 * lane) * 36 + 4 * q), im4 = *(const f32x4*)(BUf + (2 * lane + 1) * 36 + 4 * q);
#pragma unroll
                for (int i = 0; i < 4; ++i) { bu[4 * q + i].x = re4[i]; bu[4 * q + i].y = im4[i]; } }
            S5_FENCE();
            if (dir == 0) {
#pragma unroll
                for (int k = 0; k < 32; ++k) { const float nr = fma_s(lbr, sr, fma_s(nlbi, si, bu[k].x)), ni = fma_s(lbr, si, fma_s(lbi, sr, bu[k].y)); sr = nr; si = ni; *(unsigned*)(sb + k * 272 + lane * 4) = pk2(sr, si); }
            } else {
#pragma unroll
                for (int k = 31; k >= 0; --k) { const float nr = fma_s(lbr, sr, fma_s(nlbi, si, bu[k].x)), ni = fma_s(lbr, si, fma_s(lbi, sr, bu[k].y)); sr = nr; si = ni; *(unsigned*)(sb + k * 272 + lane * 4) = pk2(sr, si); }
            }
            S5_FENCE();
#pragma unroll
            for (int mt = 0; mt < 2; ++mt) { f32x4 acc = (f32x4){0.f, 0.f, 0.f, 0.f};
#pragma unroll
                for (int s = 0; s < 4; ++s) { const bf16x8 av = *(const bf16x8*)(sb + (16 * mt + (lane & 15)) * 272 + (32 * s + 8 * (lane >> 4)) * 2); acc = mfma16(av, cf[s], acc); }
#pragma unroll
                for (int i = 0; i < 4; ++i) ydst[(size_t)(rowbase + t0 + 16 * mt + 4 * (lane >> 4) + i) * 512 + g * 16 + (lane & 15)] = f2b(acc[i]); }
            S5_FENCE();
        }
    }
}
DI void s5_combine(int e, bf16* proj, const bf16* yf, const bf16* yb) {
    const KArgs& a = *kargs();
    const int gid = obid() * 512 + otid(), stride = gridDim.x * 512;
    for (int it = gid; it < MTOK * 64; it += stride) {
        const int row = it >> 6, c8 = (it & 63) * 8;
        const u32x4 vf = *(const u32x4*)(yf + (size_t)row * 512 + c8), vb = *(const u32x4*)(yb + (size_t)row * 512 + c8);
        bf16* up = proj + (size_t)row * 2304 + c8; const u32x4 vu = *(const u32x4*)up;
        float f[8], b[8], u[8]; unpack8(vf, f); unpack8(vb, b); unpack8(vu, u);
        const f32x4 d0 = *(const f32x4*)(a.in[17] + e * 512 + c8), d1 = *(const f32x4*)(a.in[17] + e * 512 + c8 + 4);
#pragma unroll
        for (int i = 0; i < 8; ++i) { const float dd = i < 4 ? d0[i] : d1[i - 4]; const float y = f[i] + b[i] + dd * u[i];
            const float z = 0.7978845608028654f * (y + 0.044715f * y * y * y); const float th = 1.f - 2.f / (1.f + __expf(2.f * z)); f[i] = 0.5f * y * (1.f + th); }
        *(u32x4*)up = pack8u(f);
    }
}
constexpr int GL_CUM = 0, GL_SEGT = 33280, GL_GLR = 35328, GL_VT = 43520, GL_A = 61952, GL_B = 80384, GL_C = 98816, GL_RS = 117248, CS = 65;
DI float logsig(float x) { return fminf(x, 0.f) - __logf(1.f + __expf(-fabsf(x))); }
DI void gla_cumsum(int e, int h, unsigned char* lds, const u32x2 glr_pre) {
    const KArgs& a = *kargs();
    const int tid = otid();
    float* cumS = (float*)(lds + GL_CUM); float* glrS = (float*)(lds + GL_GLR); float* segT = (float*)(lds + GL_SEGT);
    { const int r = tid >> 3, c4 = (tid & 7) * 4; const u32x2 v = glr_pre;
      *(f32x4*)(glrS + r * 32 + c4) = (f32x4){bflo(v.x), bfhi(v.x), bflo(v.y), bfhi(v.y)}; }
    __syncthreads();
    const int z = tid >> 8, seg = (tid >> 6) & 3, d = tid & 63;
    float c[16];
    { float w[16];
#pragma unroll
      for (int r = 0; r < 16; ++r) w[r] = a.in[19][((size_t)(e * 2 + z) * 16 + r) * 256 + h * 64 + d];
      const float b = a.in[20][(e * 2 + z) * 256 + h * 64 + d]; float cum = 0.f;
#pragma unroll
      for (int k = 0; k < 16; ++k) { const int t = z ? 16 * seg + 15 - k : 16 * seg + k; const f32x4* lr4 = (const f32x4*)(glrS + t * 32 + z * 16); float lg = b;
#pragma unroll
          for (int q = 0; q < 4; ++q) { const f32x4 x = lr4[q]; lg += x[0] * w[4 * q] + x[1] * w[4 * q + 1] + x[2] * w[4 * q + 2] + x[3] * w[4 * q + 3]; }
          cum += logsig(lg) * (1.f / 16.f); c[k] = cum; }
      segT[(z * 4 + seg) * 64 + d] = cum; }
    __syncthreads();
    { float pre = 0.f;
#pragma unroll
      for (int s2 = 0; s2 < 4; ++s2) { const bool before = z ? (s2 > seg) : (s2 < seg); const float v = segT[(z * 4 + s2) * 64 + d]; pre += before ? v : 0.f; }
#pragma unroll
      for (int k = 0; k < 16; ++k) { const int t = z ? 16 * seg + 15 - k : 16 * seg + k; cumS[(z * 64 + t) * CS + d] = c[k] + pre; } }
    __syncthreads();
}
DI void gla_stage_vt(unsigned char* lds, const u32x4 v0, const u32x4 v1) {
    const int tid = otid(), j = tid & 63, ec = (tid >> 6) * 16; bf16* Vt = (bf16*)(lds + GL_VT);
    const unsigned w[8] = {v0.x, v0.y, v0.z, v0.w, v1.x, v1.y, v1.z, v1.w};
#pragma unroll
    for (int i = 0; i < 8; ++i) { Vt[(ec + 2 * i) * 72 + j] = (bf16)(w[i] & 0xffffu); Vt[(ec + 2 * i + 1) * 72 + j] = (bf16)(w[i] >> 16); }
}
DI void gla_g1(int e, unsigned char* lds, const bf16* proj, bf16* kvbuf, float* dec) {
    const KArgs& a = *kargs();
    const int tid = otid(), lane = tid & 63, wave = tid >> 6, l31 = lane & 31, hi = lane >> 5;
    const float* cumS = (const float*)(lds + GL_CUM); bf16* Vt = (bf16*)(lds + GL_VT); bf16* KoT = (bf16*)(lds + GL_A);
#define GLA_PRE(T_, GL_, K_, V0_, V1_) do { const int n_ = (T_) >> 2, h_ = (T_) & 3; const bf16* rb_ = proj + (size_t)(n_ * 64) * 2304; \
        GL_ = *(const u32x2*)(rb_ + (size_t)(tid >> 3) * 2304 + 2048 + (tid & 7) * 4); K_ = *(const u32x4*)(rb_ + (size_t)(tid & 63) * 2304 + 768 + h_ * 64 + (tid >> 6) * 8); \
        const bf16* vp_ = rb_ + (size_t)(tid & 63) * 2304 + 1024 + h_ * 128 + (tid >> 6) * 16; V0_ = *(const u32x4*)vp_; V1_ = *(const u32x4*)(vp_ + 8); } while (0)
    u32x2 nglr = (u32x2){0u, 0u}; u32x4 nk = (u32x4){0u, 0u, 0u, 0u}, nv0 = nk, nv1 = nk;
    if (obid() < 2048) GLA_PRE(obid(), nglr, nk, nv0, nv1);
    for (int task = obid(); task < 2048; task += gridDim.x) {
        const int n = task >> 2, h = task & 3, row0 = n * 64; (void)row0; (void)n;
        const u32x2 cglr = nglr; const u32x4 kv = nk, cv0 = nv0, cv1 = nv1;
        if (task + (int)gridDim.x < 2048) GLA_PRE(task + (int)gridDim.x, nglr, nk, nv0, nv1);
        gla_cumsum(e, h, lds, cglr);
        { const int j = tid & 63, dc = (tid >> 6) * 8; float kf[8]; unpack8(kv, kf);
#pragma unroll
          for (int z = 0; z < 2; ++z)
#pragma unroll
              for (int i = 0; i < 8; ++i) { const int d = dc + i; const float tot = cumS[(z * 64 + (z ? 0 : 63)) * CS + d];
                  KoT[(z * 64 + d) * 72 + j] = f2b(kf[i] * __expf(tot - cumS[(z * 64 + j) * CS + d])); } }
        gla_stage_vt(lds, cv0, cv1);
        __syncthreads();
        { const int z = wave >> 2, eb = wave & 3; f32x16 acc[2]; acc[0] = f32x16{}; acc[1] = f32x16{};
#pragma unroll
          for (int s = 0; s < 4; ++s) { const bf16x8 av = *(const bf16x8*)(Vt + (32 * eb + l31) * 72 + 16 * s + 8 * hi);
#pragma unroll
              for (int nb = 0; nb < 2; ++nb) { const bf16x8 bv = *(const bf16x8*)(KoT + (z * 64 + 32 * nb + l31) * 72 + 16 * s + 8 * hi); acc[nb] = mfma32(av, bv, acc[nb]); } }
          bf16* dst = kvbuf + ((size_t)(task * 2 + z) * 128 + 32 * eb) * 64 + l31;
#pragma unroll
          for (int nb = 0; nb < 2; ++nb)
#pragma unroll
              for (int r = 0; r < 16; ++r) dst[crow(r, hi) * 64 + 32 * nb] = f2b(acc[nb][r]); }
        if (tid < 128) { const int z = tid >> 6, d = tid & 63; dec[(size_t)(task * 2 + z) * 64 + d] = __expf(cumS[(z * 64 + (z ? 0 : 63)) * CS + d]); }
        __syncthreads();
    }
}
DI void gla_g2(bf16* kvbuf, const float* dec) {
    const int gid = obid() * 512 + otid(), stride = gridDim.x * 512;
    for (int it = gid; it < 98304; it += stride) {
        const int dc = it & 7, ee = (it >> 3) & 127, z = (it >> 10) & 1, sh = it >> 11, seq = sh >> 2, h = sh & 3;
        const int chunk0 = seq < 4 ? seq * 64 : 256 + (seq - 4) * 32, NC = seq < 4 ? 64 : 32;
        float S[8];
#pragma unroll
        for (int i = 0; i < 8; ++i) S[i] = 0.f;
        for (int ci = 0; ci < NC; ++ci) { const int c = z ? NC - 1 - ci : ci; const int task = (chunk0 + c) * 4 + h;
            bf16* p = kvbuf + ((size_t)(task * 2 + z) * 128 + ee) * 64 + dc * 8; const u32x4 kvv = *(const u32x4*)p; float kv[8]; unpack8(kvv, kv);
            const float* dp = dec + (size_t)(task * 2 + z) * 64 + dc * 8; const f32x4 d0 = *(const f32x4*)dp, d1 = *(const f32x4*)(dp + 4);
            *(u32x4*)p = pack8u(S);
#pragma unroll
            for (int i = 0; i < 8; ++i) S[i] = (i < 4 ? d0[i] : d1[i - 4]) * S[i] + kv[i]; }
    }
}
DI void gla_g3(int e, unsigned char* lds, const bf16* proj, const bf16* kvbuf, bf16* ycat) {
    const KArgs& a = *kargs();
    const int tid = otid(), lane = tid & 63, wave = tid >> 6, l31 = lane & 31, hi = lane >> 5;
    const float* cumS = (const float*)(lds + GL_CUM); bf16* Vt = (bf16*)(lds + GL_VT);
    bf16* Qrel = (bf16*)(lds + GL_A); bf16* Krel = (bf16*)(lds + GL_B); bf16* Qd = (bf16*)(lds + GL_C); float* rs = (float*)(lds + GL_RS);
#define GLA_PRE3(T_, GL_, Q_, K_, V0_, V1_) do { const int n_ = (T_) >> 2, h_ = (T_) & 3; const bf16* rb_ = proj + (size_t)(n_ * 64) * 2304; \
        GL_ = *(const u32x2*)(rb_ + (size_t)(tid >> 3) * 2304 + 2048 + (tid & 7) * 4); const bf16* rp_ = rb_ + (size_t)(tid >> 3) * 2304 + h_ * 64 + (tid & 7) * 8; Q_ = *(const u32x4*)(rp_ + 512); K_ = *(const u32x4*)(rp_ + 768); \
        const bf16* vp_ = rb_ + (size_t)(tid & 63) * 2304 + 1024 + h_ * 128 + (tid >> 6) * 16; V0_ = *(const u32x4*)vp_; V1_ = *(const u32x4*)(vp_ + 8); } while (0)
    u32x2 nglr = (u32x2){0u, 0u}; u32x4 nq = (u32x4){0u, 0u, 0u, 0u}, nk = nq, nv0 = nq, nv1 = nq;
    if (obid() < 2048) GLA_PRE3(obid(), nglr, nq, nk, nv0, nv1);
    for (int task = obid(); task < 2048; task += gridDim.x) {
        const int n = task >> 2, h = task & 3, row0 = n * 64;
        const u32x2 cglr = nglr; const u32x4 qv = nq, kv = nk, cv0 = nv0, cv1 = nv1;
        if (task + (int)gridDim.x < 2048) GLA_PRE3(task + (int)gridDim.x, nglr, nq, nk, nv0, nv1);
        gla_cumsum(e, h, lds, cglr);
        { const int j = tid >> 3, dc = (tid & 7) * 8;
          float qf[8], kf[8]; unpack8(qv, qf); unpack8(kv, kf);
#pragma unroll
          for (int z = 0; z < 2; ++z) { float o1[8], o2[8], o3[8];
#pragma unroll
              for (int i = 0; i < 8; ++i) { const int d = dc + i; const float cj = cumS[(z * 64 + j) * CS + d], rf = cumS[(z * 64 + (z ? 32 : 31)) * CS + d]; const float q8 = qf[i] * 0.125f;
                  o1[i] = q8 * __expf(cj - rf); o2[i] = kf[i] * __expf(rf - cj); o3[i] = q8 * __expf(cj); }
              *(u32x4*)(Qrel + (z * 64 + j) * 72 + dc) = pack8u(o1); *(u32x4*)(Krel + (z * 64 + j) * 72 + dc) = pack8u(o2); *(u32x4*)(Qd + (z * 64 + j) * 72 + dc) = pack8u(o3); } }
        gla_stage_vt(lds, cv0, cv1);
        const int ib = wave >> 2, eb = wave & 3; f32x16 acc = f32x16{};
        bf16x8 bsr[2][4];
#pragma unroll
        for (int z = 0; z < 2; ++z)
#pragma unroll
            for (int s = 0; s < 4; ++s) bsr[z][s] = *(const bf16x8*)(kvbuf + ((size_t)(task * 2 + z) * 128 + 32 * eb + l31) * 64 + 16 * s + 8 * hi);
        unsigned short ogr[16];
#pragma unroll
        for (int r = 0; r < 16; ++r) ogr[r] = proj[(size_t)(row0 + 32 * ib + crow(r, hi)) * 2304 + 1536 + h * 128 + 32 * eb + l31];
        __syncthreads();
#pragma unroll
        for (int z = 0; z < 2; ++z) {
            f32x16 st[2]; st[0] = f32x16{}; st[1] = f32x16{};
#pragma unroll
            for (int s = 0; s < 4; ++s) { const bf16x8 bq = *(const bf16x8*)(Qrel + (z * 64 + 32 * ib + l31) * 72 + 16 * s + 8 * hi);
#pragma unroll
                for (int jb = 0; jb < 2; ++jb) { const bf16x8 ak = *(const bf16x8*)(Krel + (z * 64 + 32 * jb + l31) * 72 + 16 * s + 8 * hi); st[jb] = mfma32(ak, bq, st[jb]); } }
            const int i = 32 * ib + l31;
#pragma unroll
            for (int jb = 0; jb < 2; ++jb)
#pragma unroll
                for (int r = 0; r < 16; ++r) { const int j = 32 * jb + crow(r, hi); const bool keep = z ? (j >= i) : (j <= i); st[jb][r] = keep ? st[jb][r] : 0.f; }
#pragma unroll
            for (int jb = 0; jb < 2; ++jb)
#pragma unroll
                for (int s2 = 0; s2 < 2; ++s2) { float pf[8];
#pragma unroll
                    for (int q = 0; q < 8; ++q) pf[q] = st[jb][8 * s2 + q];
                    const bf16* vp = Vt + (32 * eb + l31) * 72 + 32 * jb + 16 * s2 + 4 * hi; const u32x2 lo = *(const u32x2*)vp, hi8 = *(const u32x2*)(vp + 8);
                    const u32x4 bw = (u32x4){lo.x, lo.y, hi8.x, hi8.y};
                    acc = mfma32(__builtin_bit_cast(bf16x8, pack8u(pf)), __builtin_bit_cast(bf16x8, bw), acc); }
#pragma unroll
            for (int s = 0; s < 4; ++s) { const bf16x8 aq = *(const bf16x8*)(Qd + (z * 64 + 32 * ib + l31) * 72 + 16 * s + 8 * hi);
                acc = mfma32(aq, bsr[z][s], acc); }
        }
        float sq[16];
#pragma unroll
        for (int r = 0; r < 16; ++r) { float v = acc[r] * acc[r]; v += __shfl_xor(v, 1); v += __shfl_xor(v, 2); v += __shfl_xor(v, 4); v += __shfl_xor(v, 8); v += __shfl_xor(v, 16); sq[r] = v; }
        if (l31 == 0) {
#pragma unroll
            for (int r = 0; r < 16; ++r) rs[wave * 32 + crow(r, hi)] = sq[r]; }
        __syncthreads();
        { const int ecol = h * 128 + 32 * eb + l31; const float gn = a.in[21][e * 128 + 32 * eb + l31];
#pragma unroll
          for (int r = 0; r < 16; ++r) { const int il = crow(r, hi); const float tot = rs[(ib * 4 + 0) * 32 + il] + rs[(ib * 4 + 1) * 32 + il] + rs[(ib * 4 + 2) * 32 + il] + rs[(ib * 4 + 3) * 32 + il];
              const float rstd = 1.f / sqrtf(tot * (1.f / 128.f) + 1e-6f); const size_t row = (size_t)(row0 + 32 * ib + il);
              const float og = bflo((unsigned)ogr[r]); const float sl = og / (1.f + __expf(-og));
              ycat[row * 1024 + 512 + ecol] = f2b(acc[r] * rstd * gn * sl); } }
        __syncthreads();
    }
}
template <bool DIFF>
DI void attn_unit(unsigned char* lds, const bf16* Qb, int ldq, const bf16* Kb, int ldk, const bf16* Vb, int ldv, int nkeys,
                  bf16* Ob, int ldo, int qpos0, float slope2, float negSB2, float lam, const float* sub_gain, float outscale) {
    constexpr int DK = DIFF ? 64 : 256, KW = DIFF ? 128 : 256, DVT = DIFF ? 128 : 256, KS = KW + 8, VS = 72, NS = DK / 16;
    constexpr int KCH = KW / 8, VCH = DVT / 8, NKL = 64 * KCH / 512, NVL = 64 * VCH / 512;
    bf16* Ks = (bf16*)lds; bf16* Vt = (bf16*)(lds + 34816); float* EX = (float*)lds;
    const int tid = otid(), lane = tid & 63, wave = tid >> 6, l31 = lane & 31, hi = lane >> 5, qg = wave & 3, sel = wave >> 2;
    const int kcol = DIFF ? sel * 64 : 0, vrow0 = DIFF ? 0 : sel * 128;
    bf16x8 qf[NS];
    { const bf16* qp = Qb + (size_t)(qg * 32 + l31) * ldq + kcol + 8 * hi;
#pragma unroll
      for (int s = 0; s < NS; ++s) qf[s] = *(const bf16x8*)(qp + 16 * s); }
    f32x16 O[4];
#pragma unroll
    for (int nb = 0; nb < 4; ++nb) O[nb] = f32x16{};
    float lsum = 0.f;
    const int NT = nkeys / 64;
    const float qposf = (float)(qpos0 + qg * 32 + l31);
    u32x4 kreg[NKL], vreg[NVL];
#define ATT_LOAD(t) do { \
    _Pragma("unroll") for (int i_ = 0; i_ < NKL; ++i_) { const int c_ = tid + i_ * 512, row_ = c_ / KCH, cc_ = c_ % KCH; kreg[i_] = *(const u32x4*)(Kb + (size_t)((t) * 64 + row_) * ldk + cc_ * 8); } \
    _Pragma("unroll") for (int i_ = 0; i_ < NVL; ++i_) { const int c_ = tid + i_ * 512, row_ = c_ / VCH, cc_ = c_ % VCH; vreg[i_] = *(const u32x4*)(Vb + (size_t)((t) * 64 + row_) * ldv + cc_ * 8); } } while (0)
    if (DIFF) ATT_LOAD(0);
    for (int t = 0; t < NT; ++t) {
        if (!DIFF) ATT_LOAD(t);
#pragma unroll
        for (int i = 0; i < NKL; ++i) { const int c = tid + i * 512, row = c / KCH, cc = c % KCH; *(u32x4*)(Ks + row * KS + cc * 8) = kreg[i]; }
#pragma unroll
        for (int i = 0; i < NVL; ++i) { const int c = tid + i * 512, row = c / VCH, cc = c % VCH; const unsigned w[4] = {vreg[i].x, vreg[i].y, vreg[i].z, vreg[i].w};
#pragma unroll
            for (int q = 0; q < 4; ++q) { Vt[(cc * 8 + 2 * q) * VS + row] = (bf16)(w[q] & 0xffffu); Vt[(cc * 8 + 2 * q + 1) * VS + row] = (bf16)(w[q] >> 16); } }
        __syncthreads();
        if (DIFF && t + 1 < NT) ATT_LOAD(t + 1);
        f32x16 st[2];
#pragma unroll
        for (int r = 0; r < 16; ++r) { st[0][r] = negSB2; st[1][r] = negSB2; }
#pragma unroll
        for (int s = 0; s < NS; ++s)
#pragma unroll
            for (int kb = 0; kb < 2; ++kb) { const bf16x8 av = *(const bf16x8*)(Ks + (32 * kb + l31) * KS + kcol + 16 * s + 8 * hi); st[kb] = mfma32(av, qf[s], st[kb]); }
        bf16x8 pf[2][2];
#pragma unroll
        for (int kb = 0; kb < 2; ++kb) {
            const float base = qposf - (float)(t * 64 + 32 * kb + 4 * hi);
            float p[16];
#pragma unroll
            for (int r = 0; r < 16; ++r) { float x = st[kb][r];
                if (DIFF) { const float dl = base - (float)((r & 3) + 8 * (r >> 2)); x = x - slope2 * fabsf(dl); }
                p[r] = __builtin_amdgcn_exp2f(x); lsum += p[r]; }
            pf[kb][0] = __builtin_bit_cast(bf16x8, pack8u(p)); pf[kb][1] = __builtin_bit_cast(bf16x8, pack8u(p + 8));
        }
#pragma unroll
        for (int nb = 0; nb < 4; ++nb)
#pragma unroll
            for (int kb = 0; kb < 2; ++kb)
#pragma unroll
                for (int s2 = 0; s2 < 2; ++s2) { const bf16* vp = Vt + (vrow0 + 32 * nb + l31) * VS + 32 * kb + 16 * s2 + 4 * hi; const u32x2 lo = *(const u32x2*)vp, hi8 = *(const u32x2*)(vp + 8);
                    const u32x4 bw = (u32x4){lo.x, lo.y, hi8.x, hi8.y}; O[nb] = mfma32(pf[kb][s2], __builtin_bit_cast(bf16x8, bw), O[nb]); }
        __syncthreads();
    }
#undef ATT_LOAD
    lsum += __shfl_xor(lsum, 32);
    float invl[16];
#pragma unroll
    for (int r = 0; r < 16; ++r) invl[r] = 1.f / __shfl(lsum, crow(r, hi));
#pragma unroll
    for (int nb = 0; nb < 4; ++nb)
#pragma unroll
        for (int r = 0; r < 16; ++r) O[nb][r] *= invl[r];
    if (DIFF) {
        if (sel == 1) {
#pragma unroll
            for (int nb = 0; nb < 4; ++nb)
#pragma unroll
                for (int r = 0; r < 16; ++r) EX[((qg * 4 + nb) * 16 + r) * 64 + lane] = O[nb][r]; }
        __syncthreads();
        if (sel == 0) {
            float sq[16];
#pragma unroll
            for (int r = 0; r < 16; ++r) sq[r] = 0.f;
#pragma unroll
            for (int nb = 0; nb < 4; ++nb)
#pragma unroll
                for (int r = 0; r < 16; ++r) { const float v = O[nb][r] - lam * EX[((qg * 4 + nb) * 16 + r) * 64 + lane]; O[nb][r] = v; sq[r] += v * v; }
#pragma unroll
            for (int r = 0; r < 16; ++r) { float v = sq[r]; v += __shfl_xor(v, 1); v += __shfl_xor(v, 2); v += __shfl_xor(v, 4); v += __shfl_xor(v, 8); v += __shfl_xor(v, 16);
                sq[r] = outscale / sqrtf(v * (1.f / 128.f) + 1e-6f); }
#pragma unroll
            for (int nb = 0; nb < 4; ++nb) { const float gn = sub_gain[32 * nb + l31];
#pragma unroll
                for (int r = 0; r < 16; ++r) Ob[(size_t)(qg * 32 + crow(r, hi)) * ldo + 32 * nb + l31] = f2b(O[nb][r] * sq[r] * gn); }
        }
        __syncthreads();
    } else {
#pragma unroll
        for (int nb = 0; nb < 4; ++nb)
#pragma unroll
            for (int r = 0; r < 16; ++r) Ob[(size_t)(qg * 32 + crow(r, hi)) * ldo + sel * 128 + 32 * nb + l31] = f2b(O[nb][r]);
    }
}
DI void diff_attn_phase(int o, int layer, unsigned char* lds, bf16* QKV, bf16* dummyO) {
    const KArgs& a = *kargs();
    const int lane = otid() & 63;
    const float gq = wave_max(fabsf(a.in[24][o * 64 + lane])), gk = wave_max(fabsf(a.in[25][o * 64 + lane]));
    const float negSB2 = -(8.f * gq * gk * 1.02f + 0.5f) * LOG2E;
    const float d1 = wave_sum(a.in[26][o * 64 + lane] * a.in[27][o * 64 + lane]), d2 = wave_sum(a.in[28][o * 64 + lane] * a.in[29][o * 64 + lane]);
    const float lambda_init = 0.8f - 0.6f * expf(-0.3f * (float)layer);
    const float lam = expf(d1) - expf(d2) + lambda_init;
    for (int u = obid(); u < 2048; u += gridDim.x) {
        int head, qb, L, rowbase;
        if (u < 1024) { const int seq = u >> 8, rem = u & 255; head = rem >> 5; qb = rem & 31; L = 4096; rowbase = seq * 4096; }
        else { const int u2 = u - 1024, seq = u2 >> 7, rem = u2 & 127; head = rem >> 4; qb = rem & 15; L = 2048; rowbase = 16384 + seq * 2048; }
        bf16* Qb = QKV + (size_t)(rowbase + qb * 128) * 3072 + head * 128;
        const bf16* Kb = QKV + (size_t)rowbase * 3072 + 1024 + head * 128; const bf16* Vb = QKV + (size_t)rowbase * 3072 + 2048 + head * 128;
        const float slope2 = exp2f(-(float)(head + 1)) * LOG2E;
        bf16* Od = dummyO ? dummyO + (size_t)(rowbase + qb * 128) * 1024 + head * 128 : Qb;
        attn_unit<true>(lds, Qb, 3072, Kb, 3072, Vb, 3072, L, Od, dummyO ? 1024 : 3072, qb * 128, slope2, negSB2, lam, a.in[30] + o * 128, 1.f - lambda_init);
    }
}
DI void cross_attn_phase(int layer, unsigned char* lds, bf16* qx, const bf16* kvx, bf16* dummyO) {
    const KArgs& a = *kargs();
    const int lane = otid() & 63;
    float gq = 0.f, gk = 0.f;
#pragma unroll
    for (int i = 0; i < 4; ++i) { gq = fmaxf(gq, fabsf(a.in[34][layer * 256 + lane + 64 * i])); gk = fmaxf(gk, fabsf(a.in[35][layer * 256 + lane + 64 * i])); }
    gq = wave_max(gq); gk = wave_max(gk);
    const float negSB2 = -(16.f * gq * gk * 1.02f + 0.5f) * LOG2E;
    for (int u = obid(); u < 1024; u += gridDim.x) {
        const int rb = u >> 2, head = u & 3, row0 = rb * 128; const int seq = row0 < 16384 ? (row0 >> 12) : 4 + ((row0 - 16384) >> 11);
        bf16* Qb = qx + (size_t)row0 * 1024 + head * 256; const bf16* Kb = kvx + (size_t)(seq * 256) * 2048 + head * 256; const bf16* Vb = Kb + 1024;
        bf16* Od = dummyO ? dummyO + (size_t)row0 * 1024 + head * 256 : Qb;
        attn_unit<false>(lds, Qb, 1024, Kb, 2048, Vb, 2048, 256, Od, 1024, 0, 0.f, negSB2, 0.f, nullptr, 1.f);
    }
}
DI void vt_prep(unsigned char* lds, const bf16* QKV, bf16* VT) {
    const int tid = otid(); bf16* T = (bf16*)lds;
    for (int item = obid(); item < 4096; item += gridDim.x) {
        const int n = item >> 3, head = item & 7, row0 = n * 64;
        int rowbase, L; if (row0 < 16384) { rowbase = row0 & ~4095; L = 4096; } else { rowbase = 16384 + ((row0 - 16384) & ~2047); L = 2048; }
        const int t0 = row0 - rowbase;
#pragma unroll
        for (int i = 0; i < 2; ++i) { const int c = tid + i * 512, r = c >> 4, cc = c & 15;
            *(u32x4*)(T + r * 136 + cc * 8) = *(const u32x4*)(QKV + (size_t)(row0 + r) * 3072 + 2048 + head * 128 + cc * 8); }
        __syncthreads();
        { const int e = tid >> 2, tq = (tid & 3) * 16; unsigned w[8];
#pragma unroll
          for (int i = 0; i < 8; ++i) w[i] = (unsigned)T[(tq + 2 * i) * 136 + e] | ((unsigned)T[(tq + 2 * i + 1) * 136 + e] << 16);
          bf16* dst = VT + (size_t)rowbase * 1024 + (size_t)(head * 128 + e) * L + t0 + tq;
          *(u32x4*)dst = (u32x4){w[0], w[1], w[4], w[5]}; *(u32x4*)(dst + 8) = (u32x4){w[2], w[3], w[6], w[7]}; }
        __syncthreads();
    }
}
DI void diff_unit2(unsigned char* lds, const bf16* Qb, const bf16* Kb, const bf16* VTb, int L, int kt0, int kt1,
                   bf16* Ob, int qpos0, float slope2, float negSB2, float lam, const float* sub_gain, float outscale) {
    constexpr int KS = 136, VS = 72, KBUF = 64 * KS * 2  , VBUF = 128 * VS * 2  , VOFF = 2 * KBUF;
    float* EX = (float*)lds;
    const int tid = otid(), lane = tid & 63, wave = tid >> 6, l31 = lane & 31, hi = lane >> 5, qg = wave & 3, sel = wave >> 2;
    const int kcol = sel * 64;
    bf16x8 qf[4];
    { const bf16* qp = Qb + (size_t)(qg * 32 + l31) * 3072 + kcol + 8 * hi;
#pragma unroll
      for (int s = 0; s < 4; ++s) qf[s] = *(const bf16x8*)(qp + 16 * s); }
    f32x16 O[4];
#pragma unroll
    for (int nb = 0; nb < 4; ++nb) O[nb] = f32x16{};
    float lsum = 0.f;
    const float qposf = (float)(qpos0 + qg * 32 + l31);
    const int kr0 = tid >> 4, kc0 = (tid & 15) * 8, ve0 = tid >> 3, vc0 = (tid & 7) * 8;
    const bf16* kg = Kb + (size_t)kr0 * 3072 + kc0; const bf16* vg = VTb + (size_t)ve0 * L + vc0;
    u32x4 kreg[2], vreg[2];
#define D2_LOAD(t) do { kreg[0] = *(const u32x4*)(kg + (size_t)((t) * 64) * 3072); kreg[1] = *(const u32x4*)(kg + (size_t)((t) * 64 + 32) * 3072); \
                        vreg[0] = *(const u32x4*)(vg + (t) * 64); vreg[1] = *(const u32x4*)(vg + (size_t)64 * L + (t) * 64); } while (0)
#define D2_STORE(b) do { bf16* ks_ = (bf16*)(lds + (b) * KBUF); bf16* vs_ = (bf16*)(lds + VOFF + (b) * VBUF); \
                         *(u32x4*)(ks_ + kr0 * KS + kc0) = kreg[0]; *(u32x4*)(ks_ + (kr0 + 32) * KS + kc0) = kreg[1]; \
                         *(u32x4*)(vs_ + ve0 * VS + vc0) = vreg[0]; *(u32x4*)(vs_ + (ve0 + 64) * VS + vc0) = vreg[1]; } while (0)
    D2_LOAD(kt0); D2_STORE(0);
    __syncthreads();
    for (int t = kt0; t < kt1; ++t) {
        const int b = (t - kt0) & 1;
        if (t + 1 < kt1) D2_LOAD(t + 1);
        const bf16* Ks = (const bf16*)(lds + b * KBUF); const bf16* Vt = (const bf16*)(lds + VOFF + b * VBUF);
        bf16x8 kf[4][2];
#pragma unroll
        for (int s = 0; s < 4; ++s)
#pragma unroll
            for (int kb = 0; kb < 2; ++kb) kf[s][kb] = *(const bf16x8*)(Ks + (32 * kb + l31) * KS + kcol + 16 * s + 8 * hi);
        f32x16 st[2];
#pragma unroll
        for (int r = 0; r < 16; ++r) { st[0][r] = negSB2; st[1][r] = negSB2; }
        __builtin_amdgcn_sched_barrier(0);
#pragma unroll
        for (int s = 0; s < 4; ++s)
#pragma unroll
            for (int kb = 0; kb < 2; ++kb) st[kb] = mfma32(kf[s][kb], qf[s], st[kb]);
        u32x4 vA[4], vB[4];
#define D2_VLD(dst, nb) do { _Pragma("unroll") for (int q_ = 0; q_ < 4; ++q_) dst[q_] = *(const u32x4*)(Vt + (32 * (nb) + l31) * VS + 32 * (q_ >> 1) + 16 * (q_ & 1) + 8 * hi); } while (0)
#define D2_VMM(src, nb) do { _Pragma("unroll") for (int q_ = 0; q_ < 4; ++q_) O[nb] = mfma32(pf[q_ >> 1][q_ & 1], __builtin_bit_cast(bf16x8, src[q_]), O[nb]); } while (0)
        D2_VLD(vA, 0);
        bf16x8 pf[2][2];
#pragma unroll
        for (int kb = 0; kb < 2; ++kb) {
            const float base = qposf - (float)(t * 64 + 32 * kb + 4 * hi);
            float p[16];
#pragma unroll
            for (int r = 0; r < 16; ++r) { const float dl = base - (float)((r & 3) + 8 * (r >> 2)); p[r] = __builtin_amdgcn_exp2f(st[kb][r] - slope2 * fabsf(dl)); lsum += p[r]; }
            pf[kb][0] = __builtin_bit_cast(bf16x8, pack8u(p)); pf[kb][1] = __builtin_bit_cast(bf16x8, pack8u(p + 8));
        }
        __builtin_amdgcn_sched_barrier(0);
        D2_VLD(vB, 1); D2_VMM(vA, 0);
        __builtin_amdgcn_sched_barrier(0);
        D2_VLD(vA, 2); D2_VMM(vB, 1);
        __builtin_amdgcn_sched_barrier(0);
        D2_VLD(vB, 3); D2_VMM(vA, 2);
        __builtin_amdgcn_sched_barrier(0);
        D2_VMM(vB, 3);
#undef D2_VLD
#undef D2_VMM
        if (t + 1 < kt1) D2_STORE(b ^ 1);
        __syncthreads();
    }
#undef D2_LOAD
#undef D2_STORE
    lsum += __shfl_xor(lsum, 32);
    float invl[16];
#pragma unroll
    for (int r = 0; r < 16; ++r) invl[r] = 1.f / __shfl(lsum, crow(r, hi));
#pragma unroll
    for (int nb = 0; nb < 4; ++nb)
#pragma unroll
        for (int r = 0; r < 16; ++r) O[nb][r] *= invl[r];
    if (sel == 1) {
#pragma unroll
        for (int nb = 0; nb < 4; ++nb)
#pragma unroll
            for (int r = 0; r < 16; ++r) EX[((qg * 4 + nb) * 16 + r) * 64 + lane] = O[nb][r]; }
    __syncthreads();
    if (sel == 0) {
        float sq[16];
#pragma unroll
        for (int r = 0; r < 16; ++r) sq[r] = 0.f;
#pragma unroll
        for (int nb = 0; nb < 4; ++nb)
#pragma unroll
            for (int r = 0; r < 16; ++r) { const float v = O[nb][r] - lam * EX[((qg * 4 + nb) * 16 + r) * 64 + lane]; O[nb][r] = v; sq[r] += v * v; }
#pragma unroll
        for (int r = 0; r < 16; ++r) { float v = sq[r]; v += __shfl_xor(v, 1); v += __shfl_xor(v, 2); v += __shfl_xor(v, 4); v += __shfl_xor(v, 8); v += __shfl_xor(v, 16);
            sq[r] = outscale / sqrtf(v * (1.f / 128.f) + 1e-6f); }
#pragma unroll
        for (int nb = 0; nb < 4; ++nb) { const float gn = sub_gain[32 * nb + l31];
#pragma unroll
            for (int r = 0; r < 16; ++r) Ob[(size_t)(qg * 32 + crow(r, hi)) * 3072 + 32 * nb + l31] = f2b(O[nb][r] * sq[r] * gn); }
    }
    __syncthreads();
}
DI void diff_attn_phase2(int o, int layer, unsigned char* lds, bf16* QKV, const bf16* VT) {
    const KArgs& a = *kargs();
    const int lane = otid() & 63;
    const float gq = wave_max(fabsf(a.in[24][o * 64 + lane])), gk = wave_max(fabsf(a.in[25][o * 64 + lane]));
    const float SB2 = (8.f * gq * gk * 1.02f + 0.5f) * LOG2E;
    const float d1 = wave_sum(a.in[26][o * 64 + lane] * a.in[27][o * 64 + lane]), d2 = wave_sum(a.in[28][o * 64 + lane] * a.in[29][o * 64 + lane]);
    const float lambda_init = 0.8f - 0.6f * expf(-0.3f * (float)layer);
    const float lam = expf(d1) - expf(d2) + lambda_init;
    for (int b = obid(); b < 256; b += gridDim.x)
    for (int i = 0; i < 8; ++i) { const int hb = b >> 5;
        int head, qb, L, rowbase;
        if (i < 4) { const int el = (i + (hb >> 1)) & 3; const int tA = (0x4370 >> (4 * el)) & 15, tB = (0x5261 >> (4 * el)) & 15;
            head = (hb & 1) ? tB : tA; qb = b & 31; L = 4096; rowbase = i * 4096; }
        else { const int j = i - 4, sb = (b >> 4) & 15; const int el = (j + (hb >> 1)) & 3; const int tA = (0x4370 >> (4 * el)) & 15, tB = (0x5261 >> (4 * el)) & 15;
            head = (hb & 1) ? tA : tB; qb = b & 15; L = 2048; rowbase = 16384 + (2 * j + (sb & 1)) * 2048; }
        const float slope2 = exp2f(-(float)(head + 1)) * LOG2E;
        const int dmin = (int)((2.f * SB2 + 40.f) / slope2) + 1;
        const int q0 = qb * 128;
        int kt0 = (q0 - dmin) / 64; if (q0 - dmin < 0) kt0 = 0;
        int kt1 = (q0 + 127 + dmin) / 64 + 1; if (kt1 > L / 64) kt1 = L / 64;
        bf16* Qb = QKV + (size_t)(rowbase + q0) * 3072 + head * 128;
        const bf16* Kb = QKV + (size_t)rowbase * 3072 + 1024 + head * 128; const bf16* VTb = VT + (size_t)rowbase * 1024 + (size_t)(head * 128) * L;
        diff_unit2(lds, Qb, Kb, VTb, L, kt0, kt1, Qb, q0, slope2, -SB2, lam, a.in[30] + o * 128, 1.f - lambda_init);
    }
}
DI void vt_prep_x(unsigned char* lds, const bf16* KVX, bf16* VTX) {
    const int tid = otid(); bf16* T = (bf16*)lds;
    for (int item = obid(); item < 192; item += gridDim.x) {
        const int sh = item >> 2, kt = item & 3, seq = sh >> 2, head = sh & 3;
#pragma unroll
        for (int i = 0; i < 4; ++i) { const int c = tid + i * 512, r = c >> 5, cc = c & 31;
            *(u32x4*)(T + r * 264 + cc * 8) = *(const u32x4*)(KVX + (size_t)(seq * 256 + kt * 64 + r) * 2048 + 1024 + head * 256 + cc * 8); }
        __syncthreads();
        { const int e = tid >> 1, tq = (tid & 1) * 32; unsigned w[16];
#pragma unroll
          for (int i = 0; i < 16; ++i) w[i] = (unsigned)T[(tq + 2 * i) * 264 + e] | ((unsigned)T[(tq + 2 * i + 1) * 264 + e] << 16);
          bf16* dst = VTX + (size_t)(sh * 256 + e) * 256 + kt * 64 + tq;
#pragma unroll
          for (int i = 0; i < 2; ++i) { *(u32x4*)(dst + 16 * i) = (u32x4){w[8 * i], w[8 * i + 1], w[8 * i + 4], w[8 * i + 5]}; *(u32x4*)(dst + 16 * i + 8) = (u32x4){w[8 * i + 2], w[8 * i + 3], w[8 * i + 6], w[8 * i + 7]}; } }
        __syncthreads();
    }
}
DI void cross_unit2(unsigned char* lds, const bf16* Qb, const bf16* Kb, const bf16* VTb, bf16* Ob, float negSB2) {
    constexpr int KS = 264, VS = 40, KBUF = 32 * KS * 2  , VBUF = 256 * VS * 2  , VOFF = 2 * KBUF, NT = 8;
    const int tid = otid(), lane = tid & 63, wave = tid >> 6, l31 = lane & 31, hi = lane >> 5, qg = wave & 3, sel = wave >> 2;
    const int vrow0 = sel * 128;
    bf16x8 qf[16];
    { const bf16* qp = Qb + (size_t)(qg * 32 + l31) * 1024 + 8 * hi;
#pragma unroll
      for (int s = 0; s < 16; ++s) qf[s] = *(const bf16x8*)(qp + 16 * s); }
    f32x16 O[4];
#pragma unroll
    for (int nb = 0; nb < 4; ++nb) O[nb] = f32x16{};
    float lsum = 0.f;
    const int kr0 = tid >> 5, kc0 = (tid & 31) * 8, ve0 = tid >> 2, vc0 = (tid & 3) * 8;
    const bf16* kg = Kb + (size_t)kr0 * 2048 + kc0; const bf16* vg = VTb + (size_t)ve0 * 256 + vc0;
    u32x4 kreg[2], vreg[2];
#define X2_LOAD(t) do { kreg[0] = *(const u32x4*)(kg + (size_t)((t) * 32) * 2048); kreg[1] = *(const u32x4*)(kg + (size_t)((t) * 32 + 16) * 2048); \
                        vreg[0] = *(const u32x4*)(vg + (t) * 32); vreg[1] = *(const u32x4*)(vg + 128 * 256 + (t) * 32); } while (0)
#define X2_STORE(b) do { bf16* ks_ = (bf16*)(lds + (b) * KBUF); bf16* vs_ = (bf16*)(lds + VOFF + (b) * VBUF); \
                         *(u32x4*)(ks_ + kr0 * KS + kc0) = kreg[0]; *(u32x4*)(ks_ + (kr0 + 16) * KS + kc0) = kreg[1]; \
                         *(u32x4*)(vs_ + ve0 * VS + vc0) = vreg[0]; *(u32x4*)(vs_ + (ve0 + 128) * VS + vc0) = vreg[1]; } while (0)
    X2_LOAD(0); X2_STORE(0);
    __syncthreads();
#pragma unroll 1
    for (int t = 0; t < NT; ++t) {
        const int b = t & 1;
        if (t + 1 < NT) X2_LOAD(t + 1);
        const bf16* Ks = (const bf16*)(lds + b * KBUF); const bf16* Vt = (const bf16*)(lds + VOFF + b * VBUF);
        f32x16 st;
#pragma unroll
        for (int r = 0; r < 16; ++r) st[r] = negSB2;
        __builtin_amdgcn_s_setprio(1);
#pragma unroll
        for (int s = 0; s < 16; ++s) { const bf16x8 av = *(const bf16x8*)(Ks + l31 * KS + 16 * s + 8 * hi); st = mfma32(av, qf[s], st); }
        __builtin_amdgcn_s_setprio(0);
        float p[16];
#pragma unroll
        for (int r = 0; r < 16; ++r) { p[r] = __builtin_amdgcn_exp2f(st[r]); lsum += p[r]; }
        const bf16x8 pf0 = __builtin_bit_cast(bf16x8, pack8u(p)), pf1 = __builtin_bit_cast(bf16x8, pack8u(p + 8));
        __builtin_amdgcn_s_setprio(1);
#pragma unroll
        for (int nb = 0; nb < 4; ++nb)
#pragma unroll
            for (int s2 = 0; s2 < 2; ++s2) { const u32x4 bw = *(const u32x4*)(Vt + (vrow0 + 32 * nb + l31) * VS + 16 * s2 + 8 * hi); O[nb] = mfma32(s2 ? pf1 : pf0, __builtin_bit_cast(bf16x8, bw), O[nb]); }
        __builtin_amdgcn_s_setprio(0);
        if (t + 1 < NT) X2_STORE(b ^ 1);
        __syncthreads();
    }
#undef X2_LOAD
#undef X2_STORE
    lsum += __shfl_xor(lsum, 32);
    float invl[16];
#pragma unroll
    for (int r = 0; r < 16; ++r) invl[r] = 1.f / __shfl(lsum, crow(r, hi));
#pragma unroll
    for (int nb = 0; nb < 4; ++nb)
#pragma unroll
        for (int r = 0; r < 16; ++r) Ob[(size_t)(qg * 32 + crow(r, hi)) * 1024 + sel * 128 + 32 * nb + l31] = f2b(O[nb][r] * invl[r]);
}
DI void cross_attn_phase2(int layer, unsigned char* lds, bf16* qx, const bf16* kvx, const bf16* vtx) {
    const KArgs& a = *kargs();
    const int lane = otid() & 63;
    float gq = 0.f, gk = 0.f;
#pragma unroll
    for (int i = 0; i < 4; ++i) { gq = fmaxf(gq, fabsf(a.in[34][layer * 256 + lane + 64 * i])); gk = fmaxf(gk, fabsf(a.in[35][layer * 256 + lane + 64 * i])); }
    gq = wave_max(gq); gk = wave_max(gk);
    const float negSB2 = -(16.f * gq * gk * 1.02f + 0.5f) * LOG2E;
    for (int u = obid(); u < 1024; u += gridDim.x) {
        const int rb = u >> 2, head = u & 3, row0 = rb * 128; const int seq = row0 < 16384 ? (row0 >> 12) : 4 + ((row0 - 16384) >> 11);
        bf16* Qb = qx + (size_t)row0 * 1024 + head * 256; const bf16* Kb = kvx + (size_t)(seq * 256) * 2048 + head * 256; const bf16* VTb = vtx + (size_t)((seq * 4 + head) * 256) * 256;
        cross_unit2(lds, Qb, Kb, VTb, Qb, negSB2);
    }
}
#define LAS __attribute__((address_space(3)))
#define XB_TMO      128
#define XB_XCNT(j)  (256  + 64 * (j))
#define XB_XSUB(j)  (1280 + 64 * (j))
#define XB_XGEN(j)  (2304 + 64 * (j))
#define XB_TOP      3328
#define XB_TOPGEN   3392
#define XCD_BAR_WORDS 3456
#define XB_SPIN_CAP (1u << 18)

__device__ __forceinline__ unsigned xb_ld(unsigned* p)              { return __hip_atomic_load(p, __ATOMIC_RELAXED, __HIP_MEMORY_SCOPE_AGENT); }
__device__ __forceinline__ unsigned xb_add(unsigned* p, unsigned v) { return __hip_atomic_fetch_add(p, v, __ATOMIC_RELAXED, __HIP_MEMORY_SCOPE_AGENT); }
__device__ __forceinline__ unsigned xb_xcc_id() { return (unsigned)__builtin_amdgcn_s_getreg((3 << 11) | 20) & 0xFu; }
#define XB_SPIN(cond, bar) do { unsigned _sp = 0; while (cond) { __builtin_amdgcn_s_sleep(1); \
    if ((++_sp & 255u) == 0u) { if (xb_ld(&(bar)[XB_TMO])) break; if (_sp > XB_SPIN_CAP) { atomicAdd(&(bar)[XB_TMO], 1u); break; } } } } while (0)

struct XcdBarrier {
    unsigned* bar; unsigned x;
    volatile LAS unsigned* st;
};

__device__ __forceinline__ XcdBarrier xcd_barrier_post(unsigned* bar, volatile LAS unsigned* st) {
    XcdBarrier b; b.bar = bar; b.x = xb_xcc_id(); b.st = st;
    if (threadIdx.x == 0) (void)xb_add(&bar[XB_XCNT(b.x)], 1u);
    return b;
}
__device__ __forceinline__ void xcd_barrier_complete(unsigned* bar, unsigned x, unsigned& nloc, unsigned& nx) {
    const unsigned G = gridDim.x * gridDim.y * gridDim.z;
    unsigned sum, cnt, mine, sp = 0u;
    for (;;) {
        sum = 0u; cnt = 0u; mine = 0u;
#pragma unroll
        for (unsigned j = 0; j < 16; ++j) { const unsigned c = xb_ld(&bar[XB_XCNT(j)]); sum += c; cnt += (c > 0u) ? 1u : 0u; mine = (j == x) ? c : mine; }
        if (sum == G) break;
        __builtin_amdgcn_s_sleep(1);
        if ((++sp & 255u) == 0u) { if (xb_ld(&bar[XB_TMO])) break; if (sp > XB_SPIN_CAP) { atomicAdd(&bar[XB_TMO], 1u); break; } }
    }
    nloc = mine > 0u ? mine : 1u; nx = cnt > 0u ? cnt : 1u;
}

__device__ __forceinline__ void xcd_barrier(const XcdBarrier& b) {
    asm volatile("s_waitcnt vmcnt(0)" ::: "memory");
    __syncthreads();
    if (threadIdx.x == 0) {
        unsigned* bar = b.bar;
        __builtin_amdgcn_s_waitcnt(0);
        unsigned nloc = b.st[0], nx = b.st[1];
        if (nloc == 0u) { xcd_barrier_complete(bar, b.x, nloc, nx); b.st[0] = nloc; b.st[1] = nx; }
        const unsigned old = xb_add(&bar[XB_XSUB(b.x)], 1u);
        const unsigned gen = old / nloc;
        if (old + 1u == (gen + 1u) * nloc) {
            __builtin_amdgcn_fence(__ATOMIC_RELEASE, "agent");
            asm volatile("s_waitcnt vmcnt(0)" ::: "memory");
            const unsigned og = xb_add(&bar[XB_TOP], 1u);
            const unsigned tg = og / nx;
            if (og + 1u == (tg + 1u) * nx) xb_add(&bar[XB_TOPGEN], 1u);
            else XB_SPIN(xb_ld(&bar[XB_TOPGEN]) == tg, bar);
            __builtin_amdgcn_fence(__ATOMIC_ACQUIRE, "agent");
            xb_add(&bar[XB_XGEN(b.x)], 1u);
            asm volatile("s_waitcnt vmcnt(0)" ::: "memory");
        } else {
            XB_SPIN(xb_ld(&bar[XB_XGEN(b.x)]) == gen, bar);
            __builtin_amdgcn_fence(__ATOMIC_ACQUIRE, "agent");
            asm volatile("s_waitcnt vmcnt(0)" ::: "memory");
        }
    }
    __syncthreads();
}

__global__ void __launch_bounds__(512, 2) fwd_kernel(KArgs a) {
    extern __shared__ __attribute__((aligned(16))) unsigned char lds[];
    cg::grid_group grid = cg::this_grid();
    unsigned char* ws = a.ws; float* OUT = a.out;
    volatile LAS unsigned* MISC = (volatile LAS unsigned*)((LAS unsigned char*)lds + 131072 + 64);
    if (threadIdx.x < 2) MISC[threadIdx.x] = 0u;
    if (blockIdx.x == 0) for (int i = threadIdx.x; i < XCD_BAR_WORDS; i += 512) ((unsigned*)ws)[i] = 0u;
    __syncthreads();
    grid.sync();
    (void)xcd_barrier_post((unsigned*)ws, MISC);
#define GRID_BAR() do { XcdBarrier b_; b_.bar = (unsigned*)ws; b_.x = xb_xcc_id(); b_.st = (volatile LAS unsigned*)((LAS unsigned char*)lds + 131072 + 64); xcd_barrier(b_); } while (0)
    bf16* RB = (bf16*)(ws + WS_HN);
    bf16* HN = (bf16*)a.out; bf16* BIG = (bf16*)(ws + WS_BIG); bf16* MN = (bf16*)(ws + WS_MN);
    bf16* XBB = (bf16*)(ws + WS_XBB); float* RSQ = (float*)(ws + WS_ROWSQ);
    bf16* YF = HN; bf16* YB = HN + (size_t)MTOK * 512; bf16* KVB = (bf16*)(ws + WS_KV); float* DEC = (float*)(ws + WS_DEC); bf16* KVX = (bf16*)(ws + WS_KVX);
#pragma unroll 1
    for (int layer = 0; layer < 4; ++layer) {
        const bool even = !(layer & 1); const int hl = layer >> 1;
#pragma unroll 1
        for (int step = 0; step < 15; ++step) {
            bool sync = true;
            switch (step) {
            case 0:
              for (int rep_ = 0; rep_ < (PROBE == 6 ? 2 : 1); ++rep_) {
                convert_weights(layer, lds);
                if (layer == 0) prep_rows(kargs()->in[0], kargs()->in[1], RB, RSQ);
                norm_rows<false>(kargs()->in[2], kargs()->in[3], 1024, 3072, kargs()->in[6] + layer * 1024, MN, nullptr);
              }
                break;
            case 1: for (int rep_ = 0; rep_ < (PROBE == 1 ? 2 : 1); ++rep_) if (even) run_gemm<MTOK, 2304, 1024, 1024>(lds, RB, (const bf16*)(ws + W_IN), pg8::EpiB<0, true>{BIG, 2304, RSQ}); else run_gemm<MTOK, 3072, 1024, 1024>(lds, RB, (const bf16*)(ws + W_IN), pg8::EpiQKV{BIG, RSQ, kargs()->in[24] + hl * 64, kargs()->in[25] + hl * 64, 0.125f * LOG2E}); break;
            case 2:
                if (even) { for (int rep_ = 0; rep_ < (PROBE == 2 ? 2 : 1); ++rep_) { s5_phase(hl, lds, BIG, YF, YB); __syncthreads(); } for (int rep_ = 0; rep_ < (PROBE == 3 ? 2 : 1); ++rep_) gla_g1(hl, lds, BIG, KVB, DEC); }
                else vt_prep(lds, BIG, HN);
                break;
            case 3:
                if (even) { gla_g2(KVB, DEC); s5_combine(hl, BIG, YF, YB); }
                else diff_attn_phase2(hl, layer, lds, BIG, HN);
                break;
            case 4:
                if (even) { for (int rep_ = 0; rep_ < (PROBE == 3 ? 2 : 1); ++rep_) gla_g3(hl, lds, BIG, KVB, HN); run_gemm<MTOK, 512, 512, 2304>(lds, BIG, (const bf16*)(ws + W_GLU), pg8::EpiGlu{BIG, 2304, HN, 1024}); }
                else sync = false;
                break;
            case 5: if (even) run_gemm<MTOK, 1024, 1024, 1024>(lds, HN, (const bf16*)(ws + W_OUT), pg8::EpiRes3<false>{RB, RSQ + 1 * 524288, nullptr}); else run_gemm<MTOK, 1024, 1024, 3072>(lds, BIG, (const bf16*)(ws + W_OUT), pg8::EpiRes3<false>{RB, RSQ + 1 * 524288, nullptr}); break;
            case 6: sync = false; break;
            case 7: for (int rep_ = 0; rep_ < (PROBE == 1 ? 2 : 1); ++rep_) run_gemm<MTOK, 1024, 1024, 1024>(lds, RB, (const bf16*)(ws + W_XQ), pg8::EpiB<0, true>{BIG, 1024, RSQ + 1 * 524288}); sync = false; break;
            case 8: for (int rep_ = 0; rep_ < (PROBE == 1 ? 2 : 1); ++rep_) run_gemm<3072, 2048, 1024, 1024>(lds, MN, (const bf16*)(ws + W_XKV), pg8::EpiB<0>{KVX, 2048, nullptr}); break;
            case 9:
                segnorm(BIG, 1024, MTOK, 2, 256, kargs()->in[34] + layer * 256, 0.0625f * LOG2E, 2, kargs()->in[34] + layer * 256, 0.0625f * LOG2E);
                segnorm(KVX, 2048, 3072, 2, 256, kargs()->in[35] + layer * 256, 1.f, 2, kargs()->in[35] + layer * 256, 1.f);
                vt_prep_x(lds, KVX, (bf16*)(ws + WS_KVX + 16 * MiB));
                break;
            case 10: cross_attn_phase2(layer, lds, BIG, KVX, (const bf16*)(ws + WS_KVX + 16 * MiB)); break;
            case 11: run_gemm<MTOK, 1024, 1024, 1024>(lds, BIG, (const bf16*)(ws + W_XO), pg8::EpiRes3<false>{RB, RSQ + 2 * 524288, nullptr}); break;
            case 12: sync = false; break;
            case 13: for (int rep_ = 0; rep_ < (PROBE == 1 ? 2 : 1); ++rep_) run_gemm<MTOK, 4096, 1024, 1024>(lds, RB, (const bf16*)(ws + W_1), pg8::EpiB<1, true>{BIG, 4096, RSQ + 2 * 524288}); break;
            default: if (layer == 3) run_gemm<MTOK, 1024, 4096, 4096>(lds, BIG, (const bf16*)(ws + W_2), pg8::EpiRes3<true>{RB, nullptr, OUT});
                     else run_gemm<MTOK, 1024, 4096, 4096>(lds, BIG, (const bf16*)(ws + W_2), pg8::EpiRes3<false>{RB, RSQ, nullptr}); break;
            }
            if (sync) { GRID_BAR(); if (PROBE == 4) GRID_BAR(); }
        }
    }
}
extern "C" void kernel_launch(void* const* d_in, const int* in_sizes, int n_in, void* d_out, int out_size, void* d_ws, size_t ws_size, hipStream_t stream) {
    static int grid = 0;
    if (grid == 0) {
        if (n_in != 38 || out_size != MTOK * 1024 || ws_size < WS_END) { fprintf(stderr, "kernel_launch: unexpected shapes n_in %d out %d ws %zu (need %zu)\n", n_in, out_size, ws_size, (size_t)WS_END); grid = -1; return; }
        int dev = 0, cus = 0, per_cu = 0;
        hipGetDevice(&dev); hipDeviceGetAttribute(&cus, hipDeviceAttributeMultiprocessorCount, dev);
        if (hipFuncSetAttribute((const void*)fwd_kernel, hipFuncAttributeMaxDynamicSharedMemorySize, LDS_BYTES) != hipSuccess) { fprintf(stderr, "kernel_launch: hipFuncSetAttribute failed\n"); grid = -1; return; }
        if (hipOccupancyMaxActiveBlocksPerMultiprocessor(&per_cu, (const void*)fwd_kernel, 512, LDS_BYTES) != hipSuccess || per_cu < 1) { fprintf(stderr, "kernel_launch: occupancy query gave %d\n", per_cu); per_cu = 1; }
        (void)hipGetLastError();
        grid = cus * (per_cu > 1 ? 1 : per_cu);
        if (grid <= 0) grid = 256;
    }
    if (grid < 0) return;
    KArgs a{};
    for (int i = 0; i < 38; ++i) a.in[i] = (const float*)d_in[i];
    a.out = (float*)d_out; a.ws = (unsigned char*)d_ws;
    void* args[] = {&a};
    hipError_t e = hipLaunchCooperativeKernel((const void*)fwd_kernel, dim3(grid), dim3(512), args, LDS_BYTES, stream);
    if (e != hipSuccess) fprintf(stderr, "cooperative launch failed: %s (grid %d)\n", hipGetErrorString(e), grid);
}
```

```cpp
#include <hip/hip_runtime.h>
#include <hip/hip_cooperative_groups.h>
#include <cstdio>
#include <cstdint>
namespace cg = cooperative_groups;
#ifndef PROBE
#define PROBE 0
#endif
__device__ __forceinline__ int otid() { int t = threadIdx.x; asm volatile("" : "+v"(t)); return t; }
__device__ __forceinline__ int obid() { int b = blockIdx.x; asm volatile("" : "+s"(b)); return b; }
namespace pg8 {
#define PG8_LAS __attribute__((address_space(3)))
typedef unsigned short bf16_t;
typedef short bf16x8 __attribute__((ext_vector_type(8)));
typedef float f32x4 __attribute__((ext_vector_type(4)));
typedef unsigned u32x4 __attribute__((ext_vector_type(4)));
constexpr int BM = 256, BK = 64, HALF = 128, HTB = HALF * BK * 2  , STAGE_BYTES = 8 * HTB, NXCD = 8, WGM = 8;

__host__ __device__ __forceinline__ int lds_byte(int r, int c) { const int st = (r >> 4) * 2 + (c >> 5), rr = r & 15, cc = c & 31, ob = rr * 64 + cc * 2; return st * 1024 + (ob ^ (((ob >> 9) & 1) << 5)); }
__host__ __device__ __forceinline__ void stage_rc(int b, int& R, int& C) { const int st = b / 1024, sb = b % 1024, swz = sb ^ (((sb >> 9) & 1) << 5); R = (st >> 1) * 16 + swz / 64; C = (st & 1) * 32 + (swz % 64) / 2; }
__host__ __device__ __forceinline__ int perm32(int rho) { const int n = rho >> 4, i = rho & 15; return 8 * (i >> 2) + 4 * n + (i & 3); }

struct Unit { int pm, pn; };
struct Gemm { const bf16_t* A; int lda; const bf16_t* Bt; int M, N, K; };

struct StaticOrder {
    int nM, nN, nwg, G, c;
    __host__ __device__ void init(int M, int N, int G_, int c_) { nM = M / BM; nN = N / BM; nwg = nM * nN; G = G_; c = c_; }
    __host__ __device__ bool next(int i, Unit& u) const {
        const long L = (long)i * G + c; if (L >= nwg) return false;
        int wgid = (int)L; { const int q = nwg / NXCD, r = nwg % NXCD, xcd = wgid % NXCD, off = wgid / NXCD; wgid = (xcd < r ? xcd * (q + 1) : r * (q + 1) + (xcd - r) * q) + off; }
        const int nig = WGM * nN, gid = wgid / nig, fm = gid * WGM, gsz = (nM - fm) < WGM ? (nM - fm) : WGM;
        u.pm = fm + ((wgid % nig) % gsz); u.pn = (wgid % nig) / gsz; return true;
    }
    __device__ __forceinline__ void a_ready(const Unit&) const {}
    __device__ __forceinline__ void done(const Unit&) const {}
};

__device__ __forceinline__ unsigned cvt_pk_bf16(float lo, float hi) { unsigned r; asm volatile("v_cvt_pk_bf16_f32 %0, %1, %2" : "=v"(r) : "v"(lo), "v"(hi)); return r; }
typedef float f32x2 __attribute__((ext_vector_type(2)));
typedef float f32x2e __attribute__((ext_vector_type(2)));
typedef __bf16 bf16x2e __attribute__((ext_vector_type(2)));
__device__ __forceinline__ unsigned pk2e(float lo, float hi) { f32x2e v = {lo, hi}; bf16x2e b = __builtin_convertvector(v, bf16x2e); return __builtin_bit_cast(unsigned, b); }
template <int ACT  , bool RS = false  > struct EpiB {
    static constexpr bool PERM = true, AFTER_DRAIN = false;
    bf16_t* O; int ldc; const float* rsq;
    __device__ __forceinline__ void operator()(const f32x4 (&acc)[2][2][4][2], const Unit& u, int wr, int wc, int fr, int fq) const {
        const int row0 = u.pm * BM + wr * 64 + fr, col0 = u.pn * BM + wc * 32 + 8 * fq;
#pragma unroll
        for (int ai = 0; ai < 2; ++ai)
#pragma unroll
            for (int m = 0; m < 4; ++m) { bf16_t* rowp = O + (size_t)(row0 + ai * HALF + m * 16) * ldc + col0;
                float rstd = 1.f; if (RS) { const f32x4 r0 = *((const f32x4*)(rsq + (size_t)(row0 + ai * HALF + m * 16) * 16) + fq); float tot = (r0[0] + r0[1]) + (r0[2] + r0[3]); tot += __shfl_xor(tot, 16); tot += __shfl_xor(tot, 32); rstd = 1.f / sqrtf(tot * (1.f / 1024.f) + 1e-6f); }
#pragma unroll
                for (int bj = 0; bj < 2; ++bj) { f32x4 v0 = acc[ai][bj][m][0], v1 = acc[ai][bj][m][1];
                    if (RS) { v0 = v0 * rstd; v1 = v1 * rstd; }
                    if (ACT == 1) {
#pragma unroll
                        for (int q = 0; q < 4; ++q) { float a = v0[q] > 0.f ? v0[q] : 0.f; v0[q] = a * a; float b = v1[q] > 0.f ? v1[q] : 0.f; v1[q] = b * b; } }
                    u32x4 w; w.x = pk2e(v0[0], v0[1]); w.y = pk2e(v0[2], v0[3]); w.z = pk2e(v1[0], v1[1]); w.w = pk2e(v1[2], v1[3]);
                    *(u32x4*)(rowp + bj * HALF) = w; } }
    }
};
struct EpiRes {
    static constexpr bool PERM = false, AFTER_DRAIN = false;
    float* X; int ldc;
    __device__ __forceinline__ void operator()(const f32x4 (&acc)[2][2][4][2], const Unit& u, int wr, int wc, int fr, int fq) const {
        const int row0 = u.pm * BM + wr * 64 + fr, col0 = u.pn * BM + wc * 32 + 4 * fq;
#pragma unroll
        for (int ai = 0; ai < 2; ++ai)
#pragma unroll
            for (int m = 0; m < 4; ++m) { float* rowp = X + (size_t)(row0 + ai * HALF + m * 16) * ldc + col0;
#pragma unroll
                for (int bj = 0; bj < 2; ++bj)
#pragma unroll
                    for (int n = 0; n < 2; ++n) { f32x4* p = (f32x4*)(rowp + bj * HALF + n * 16); const f32x4 b = *p; *p = b + acc[ai][bj][m][n]; } }
    }
};
template <bool LAST> struct EpiRes3 {
    static constexpr bool PERM = true, AFTER_DRAIN = false;
    bf16_t* R; float* rsq; float* out;
    __device__ __forceinline__ void operator()(const f32x4 (&acc)[2][2][4][2], const Unit& u, int wr, int wc, int fr, int fq) const {
        const int row0 = u.pm * BM + wr * 64 + fr, col0 = u.pn * BM + wc * 32 + 8 * fq;
#pragma unroll
        for (int ai = 0; ai < 2; ++ai)
#pragma unroll
            for (int m = 0; m < 4; ++m) { const size_t row = (size_t)(row0 + ai * HALF + m * 16); bf16_t* bp = R + row * 1024 + col0; float ss = 0.f;
#pragma unroll
                for (int bj = 0; bj < 2; ++bj) { const u32x4 rv = *(const u32x4*)(bp + bj * HALF);
                    f32x4 v0, v1; v0[0] = __uint_as_float(rv.x << 16); v0[1] = __uint_as_float(rv.x & 0xffff0000u); v0[2] = __uint_as_float(rv.y << 16); v0[3] = __uint_as_float(rv.y & 0xffff0000u);
                    v1[0] = __uint_as_float(rv.z << 16); v1[1] = __uint_as_float(rv.z & 0xffff0000u); v1[2] = __uint_as_float(rv.w << 16); v1[3] = __uint_as_float(rv.w & 0xffff0000u);
                    v0 = v0 + acc[ai][bj][m][0]; v1 = v1 + acc[ai][bj][m][1];
                    if (LAST) { f32x4* p = (f32x4*)(out + row * 1024 + col0 + bj * HALF); p[0] = v0; p[1] = v1; }
                    else { u32x4 w; w.x = pk2e(v0[0], v0[1]); w.y = pk2e(v0[2], v0[3]); w.z = pk2e(v1[0], v1[1]); w.w = pk2e(v1[2], v1[3]); *(u32x4*)(bp + bj * HALF) = w;
                        const float a0 = __uint_as_float(w.x << 16), a1 = __uint_as_float(w.x & 0xffff0000u), a2 = __uint_as_float(w.y << 16), a3 = __uint_as_float(w.y & 0xffff0000u);
                        const float a4 = __uint_as_float(w.z << 16), a5 = __uint_as_float(w.z & 0xffff0000u), a6 = __uint_as_float(w.w << 16), a7 = __uint_as_float(w.w & 0xffff0000u);
                        ss += ((a0 * a0 + a1 * a1) + (a2 * a2 + a3 * a3)) + ((a4 * a4 + a5 * a5) + (a6 * a6 + a7 * a7)); } }
                if (!LAST) { ss += __shfl_xor(ss, 16); ss += __shfl_xor(ss, 32); if (fq == 0) rsq[row * 16 + u.pn * 4 + wc] = ss; } }
    }
};
struct EpiQKV {
    static constexpr bool PERM = true, AFTER_DRAIN = false;
    bf16_t* O; const float* rsq; const float* gq; const float* gk; float qscale;
    __device__ __forceinline__ void operator()(const f32x4 (&acc)[2][2][4][2], const Unit& u, int wr, int wc, int fr, int fq) const {
        const int row0 = u.pm * BM + wr * 64 + fr; const bool isqk = u.pn < 8;
        const float* g = u.pn < 4 ? gq : gk; const float sc = u.pn < 4 ? qscale : 1.f;
        f32x4 gv[2][2];
#pragma unroll
        for (int bj = 0; bj < 2; ++bj) { gv[bj][0] = *(const f32x4*)(g + 32 * bj + 8 * fq); gv[bj][1] = *(const f32x4*)(g + 32 * bj + 8 * fq + 4); }
#pragma unroll
        for (int ai = 0; ai < 2; ++ai)
#pragma unroll
            for (int m = 0; m < 4; ++m) { const size_t row = (size_t)(row0 + ai * HALF + m * 16);
                const f32x4 r0 = *((const f32x4*)(rsq + row * 16) + fq); float tot = (r0[0] + r0[1]) + (r0[2] + r0[3]); tot += __shfl_xor(tot, 16); tot += __shfl_xor(tot, 32);
                const float rstd = 1.f / sqrtf(tot * (1.f / 1024.f) + 1e-6f);
                f32x4 v[2][2]; float ss = 0.f;
#pragma unroll
                for (int bj = 0; bj < 2; ++bj)
#pragma unroll
                    for (int n = 0; n < 2; ++n) { v[bj][n] = acc[ai][bj][m][n] * rstd; ss += (v[bj][n][0] * v[bj][n][0] + v[bj][n][1] * v[bj][n][1]) + (v[bj][n][2] * v[bj][n][2] + v[bj][n][3] * v[bj][n][3]); }
                ss += __shfl_xor(ss, 16); ss += __shfl_xor(ss, 32);
                const float rg = isqk ? sc / sqrtf(ss * (1.f / 64.f) + 1e-6f) : 1.f;
#pragma unroll
                for (int bj = 0; bj < 2; ++bj) { f32x4 v0 = v[bj][0], v1 = v[bj][1];
                    if (isqk) { v0 = v0 * gv[bj][0] * rg; v1 = v1 * gv[bj][1] * rg; }
                    u32x4 w; w.x = pk2e(v0[0], v0[1]); w.y = pk2e(v0[2], v0[3]); w.z = pk2e(v1[0], v1[1]); w.w = pk2e(v1[2], v1[3]);
                    const int col = isqk ? (u.pn * BM + 64 * wc + 32 * bj + 8 * fq) : (u.pn * BM + bj * HALF + wc * 32 + 8 * fq);
                    *(u32x4*)(O + row * 3072 + col) = w; } }
    }
};
struct EpiGlu {
    static constexpr bool PERM = true, AFTER_DRAIN = false;
    const bf16_t* Y; int ldy; bf16_t* O; int ldc;
    __device__ __forceinline__ void operator()(const f32x4 (&acc)[2][2][4][2], const Unit& u, int wr, int wc, int fr, int fq) const {
        const int row0 = u.pm * BM + wr * 64 + fr, col0 = u.pn * BM + wc * 32 + 8 * fq;
#pragma unroll
        for (int ai = 0; ai < 2; ++ai)
#pragma unroll
            for (int m = 0; m < 4; ++m) { const size_t row = (size_t)(row0 + ai * HALF + m * 16);
#pragma unroll
                for (int bj = 0; bj < 2; ++bj) { const f32x4 v0 = acc[ai][bj][m][0], v1 = acc[ai][bj][m][1];
                    const u32x4 yv = *(const u32x4*)(Y + row * ldy + col0 + bj * HALF);
                    float y[8]; y[0] = __uint_as_float(yv.x << 16); y[1] = __uint_as_float(yv.x & 0xffff0000u); y[2] = __uint_as_float(yv.y << 16); y[3] = __uint_as_float(yv.y & 0xffff0000u);
                    y[4] = __uint_as_float(yv.z << 16); y[5] = __uint_as_float(yv.z & 0xffff0000u); y[6] = __uint_as_float(yv.w << 16); y[7] = __uint_as_float(yv.w & 0xffff0000u);
                    float o[8];
#pragma unroll
                    for (int q = 0; q < 4; ++q) { o[q] = y[q] / (1.f + __expf(-v0[q])); o[4 + q] = y[4 + q] / (1.f + __expf(-v1[q])); }
                    u32x4 w; w.x = pk2e(o[0], o[1]); w.y = pk2e(o[2], o[3]); w.z = pk2e(o[4], o[5]); w.w = pk2e(o[6], o[7]);
                    *(u32x4*)(O + row * ldc + col0 + bj * HALF) = w; } }
    }
};
template <class Epi, class Sched, bool ALIGN_EPI = false, bool SP2 = false>
__device__ __forceinline__ void gemm_phase(PG8_LAS unsigned char* lds, const Gemm g, const Sched& S, const Epi& E) {
    const int tid = otid(), wid = __builtin_amdgcn_readfirstlane(tid >> 6), lane = tid & 63, wr = wid >> 2, wc = wid & 3, fr = lane & 15, fq = lane >> 4;
    const int K = g.K, nt = K / BK;
    unsigned voffA[2], voffB[2];
#pragma unroll
    for (int i = 0; i < 2; ++i) { int R, C; stage_rc(tid * 16 + i * 8192, R, C); const int Rb = Epi::PERM ? ((R & ~31) + perm32(R & 31)) : R;
        voffA[i] = (unsigned)(R * g.lda + C) * 2u; voffB[i] = (unsigned)(Rb * K + C) * 2u; }
    const size_t kstep = (size_t)(BK * 2);
    const size_t hstep = (size_t)HALF * K * 2;
    const size_t tstep = 2 * hstep;
    const size_t hstepA = (size_t)HALF * g.lda * 2, tstepA = 2 * hstepA;
    const unsigned ldsw = (unsigned)wid * 1024u;
    const int aoff = lds_byte(wr * 64 + fr, fq * 8), boff = lds_byte(wc * 32 + fr, fq * 8);
#define PG8_SA(b, h) (((b) * 2 + (h)) * HTB)
#define PG8_SB(b, h) ((4 + (b) * 2 + (h)) * HTB)
#define PG8_STAGE(bufoff, gbase, voff) do { _Pragma("unroll") for (int _i = 0; _i < 2; ++_i) \
        __builtin_amdgcn_global_load_lds((const unsigned*)((const char*)(gbase) + (voff)[_i]), (PG8_LAS unsigned*)(lds + (bufoff) + ldsw + _i * 8192), 16, 0, 0); } while (0)
#define PG8_LDA(dst, b, h) do { _Pragma("unroll") for (int m = 0; m < 4; ++m) _Pragma("unroll") for (int k = 0; k < 2; ++k) dst[m][k] = *(const PG8_LAS bf16x8*)(lds + PG8_SA(b, h) + aoff + m * 2048 + k * 1024); } while (0)
#define PG8_LDB(dst, b, h) do { _Pragma("unroll") for (int n = 0; n < 2; ++n) _Pragma("unroll") for (int k = 0; k < 2; ++k) dst[n][k] = *(const PG8_LAS bf16x8*)(lds + PG8_SB(b, h) + boff + n * 2048 + k * 1024); } while (0)
#define PG8_MMA(ai, bj, At, Bt) do { __builtin_amdgcn_s_setprio(1); _Pragma("unroll") for (int m = 0; m < 4; ++m) _Pragma("unroll") for (int n = 0; n < 2; ++n) _Pragma("unroll") for (int k = 0; k < 2; ++k) \
        acc[ai][bj][m][n] = __builtin_amdgcn_mfma_f32_16x16x32_bf16(Bt[n][k], At[m][k], acc[ai][bj][m][n], 0, 0, 0); __builtin_amdgcn_s_setprio(0); } while (0)
#define PG8_WAIT_V(n) asm volatile("s_waitcnt vmcnt(" #n ")" ::: "memory")
#define PG8_WAIT_L(n) asm volatile("s_waitcnt lgkmcnt(" #n ")" ::: "memory")
#define PG8_BAR __builtin_amdgcn_s_barrier()
#define PG8_SCHED __builtin_amdgcn_sched_barrier(0)
    Unit cur, nxt; int ui = 0;
    if (!S.next(0, cur)) return;
    f32x4 acc[2][2][4][2];
#pragma unroll
    for (int a = 0; a < 2; ++a)
#pragma unroll
        for (int b = 0; b < 2; ++b)
#pragma unroll
            for (int m = 0; m < 4; ++m)
#pragma unroll
                for (int n = 0; n < 2; ++n) acc[a][b][m][n] = (f32x4){0.f, 0.f, 0.f, 0.f};
    bf16x8 At[4][2], B0[2][2], B1[2][2];
    const char* cA = (const char*)g.A + (size_t)cur.pm * tstepA; const char* cB = (const char*)g.Bt + (size_t)cur.pn * tstep;
    S.a_ready(cur);
    if constexpr (SP2) {
        PG8_STAGE(PG8_SB(0, 0), cB, voffB); PG8_STAGE(PG8_SB(0, 1), cB + hstep, voffB); PG8_STAGE(PG8_SA(0, 0), cA, voffA); PG8_STAGE(PG8_SA(0, 1), cA + hstepA, voffA);
        if (wr == 1) PG8_BAR;
        PG8_WAIT_V(2); PG8_BAR;
        PG8_STAGE(PG8_SB(1, 0), cB + kstep, voffB); PG8_STAGE(PG8_SA(1, 0), cA + kstep, voffA); PG8_STAGE(PG8_SB(1, 1), cB + hstep + kstep, voffB);
        PG8_WAIT_V(6); PG8_BAR;
    } else {
        PG8_STAGE(PG8_SB(0, 0), cB, voffB); PG8_STAGE(PG8_SA(0, 0), cA, voffA); PG8_STAGE(PG8_SB(0, 1), cB + hstep, voffB); PG8_STAGE(PG8_SA(0, 1), cA + hstepA, voffA);
        if (wr == 1) PG8_BAR;
        PG8_WAIT_V(4); PG8_BAR;
        PG8_STAGE(PG8_SB(1, 0), cB + kstep, voffB); PG8_STAGE(PG8_SA(1, 0), cA + kstep, voffA); PG8_STAGE(PG8_SB(1, 1), cB + hstep + kstep, voffB);
        PG8_WAIT_V(6); PG8_BAR;
    }
    for (;;) {
        const bool has_next = S.next(ui + 1, nxt);
        const char* nA = has_next ? (const char*)g.A + (size_t)nxt.pm * tstepA : cA; const char* nB = has_next ? (const char*)g.Bt + (size_t)nxt.pn * tstep : cB;
        for (int t = 0; t < nt; t += 2) {
            const bool last = (t == nt - 2);
            const char* a1 = cA + (size_t)(t + 1) * kstep;
            const char* a2 = last ? nA : cA + (size_t)(t + 2) * kstep; const char* b2 = last ? nB : cB + (size_t)(t + 2) * kstep;
            const char* a3 = a2 + kstep; const char* b3 = b2 + kstep;
            if (last && has_next) S.a_ready(nxt);
            if constexpr (SP2) {
            PG8_LDB(B0, 0, 0); PG8_LDB(B1, 0, 1); PG8_SCHED; PG8_LDA(At, 0, 0); PG8_STAGE(PG8_SA(1, 1), a1 + hstepA, voffA);
            PG8_WAIT_V(8); PG8_WAIT_L(0); PG8_BAR; PG8_MMA(0, 0, At, B0); PG8_MMA(0, 1, At, B1); PG8_BAR; PG8_SCHED;
            PG8_LDA(At, 0, 1); PG8_STAGE(PG8_SB(0, 0), b2, voffB); PG8_STAGE(PG8_SB(0, 1), b2 + hstep, voffB); PG8_STAGE(PG8_SA(0, 0), a2, voffA);
            PG8_WAIT_V(8); PG8_WAIT_L(0); PG8_BAR; PG8_MMA(1, 0, At, B0); PG8_MMA(1, 1, At, B1); PG8_BAR; PG8_SCHED;
            PG8_LDB(B0, 1, 0); PG8_LDB(B1, 1, 1); PG8_SCHED; PG8_LDA(At, 1, 0); PG8_STAGE(PG8_SA(0, 1), a2 + hstepA, voffA);
            PG8_WAIT_V(8); PG8_WAIT_L(0); PG8_BAR; PG8_MMA(0, 0, At, B0); PG8_MMA(0, 1, At, B1); PG8_BAR; PG8_SCHED;
            PG8_LDA(At, 1, 1); PG8_STAGE(PG8_SB(1, 0), b3, voffB); PG8_STAGE(PG8_SB(1, 1), b3 + hstep, voffB); PG8_STAGE(PG8_SA(1, 0), a3, voffA);
            PG8_WAIT_V(8); PG8_WAIT_L(0); PG8_BAR; PG8_MMA(1, 0, At, B0); PG8_MMA(1, 1, At, B1); PG8_BAR; PG8_SCHED;
            } else {
            PG8_LDB(B0, 0, 0); PG8_SCHED; PG8_LDA(At, 0, 0); PG8_STAGE(PG8_SA(1, 1), a1 + hstepA, voffA);
            PG8_WAIT_L(8); PG8_BAR; PG8_WAIT_L(0); PG8_MMA(0, 0, At, B0); PG8_BAR; PG8_SCHED;
            PG8_LDB(B1, 0, 1); PG8_STAGE(PG8_SB(0, 0), b2, voffB);
            PG8_BAR; PG8_WAIT_L(0); PG8_MMA(0, 1, At, B1); PG8_BAR;
            PG8_LDA(At, 0, 1); PG8_STAGE(PG8_SA(0, 0), a2, voffA);
            PG8_BAR; PG8_WAIT_L(0); PG8_MMA(1, 0, At, B0); PG8_BAR; PG8_SCHED;
            PG8_STAGE(PG8_SB(0, 1), b2 + hstep, voffB);
            PG8_WAIT_V(6); PG8_BAR; PG8_MMA(1, 1, At, B1); PG8_BAR;
            PG8_LDB(B0, 1, 0); PG8_SCHED; PG8_LDA(At, 1, 0); PG8_STAGE(PG8_SA(0, 1), a2 + hstepA, voffA);
            PG8_WAIT_L(8); PG8_BAR; PG8_WAIT_L(0); PG8_MMA(0, 0, At, B0); PG8_BAR; PG8_SCHED;
            PG8_LDB(B1, 1, 1); PG8_STAGE(PG8_SB(1, 0), b3, voffB);
            PG8_BAR; PG8_WAIT_L(0); PG8_MMA(0, 1, At, B1); PG8_BAR;
            PG8_LDA(At, 1, 1); PG8_STAGE(PG8_SA(1, 0), a3, voffA);
            PG8_BAR; PG8_WAIT_L(0); PG8_MMA(1, 0, At, B0); PG8_BAR; PG8_SCHED;
            PG8_STAGE(PG8_SB(1, 1), b3 + hstep, voffB);
            PG8_WAIT_V(6); PG8_BAR; PG8_MMA(1, 1, At, B1); PG8_BAR;
            }
        }
        if constexpr (ALIGN_EPI) { if (wr == 0) PG8_BAR; }
        if constexpr (!Epi::AFTER_DRAIN) { E(acc, cur, wr, wc, fr, fq); S.done(cur); }
        if (!has_next) break;
#pragma unroll
        for (int a = 0; a < 2; ++a)
#pragma unroll
            for (int b = 0; b < 2; ++b)
#pragma unroll
                for (int m = 0; m < 4; ++m)
#pragma unroll
                    for (int n = 0; n < 2; ++n) acc[a][b][m][n] = (f32x4){0.f, 0.f, 0.f, 0.f};
        cur = nxt; cA = nA; cB = nB; ++ui;
        if constexpr (ALIGN_EPI) { if (wr == 1) PG8_BAR; }
    }
    PG8_WAIT_V(0);
    if constexpr (!ALIGN_EPI) { if (wr == 0) PG8_BAR; }
    PG8_BAR;
    if constexpr (Epi::AFTER_DRAIN) { E.fused(acc, cur, wr, wc, fr, fq, lds, wid, lane); S.done(cur); }
#undef PG8_SA
#undef PG8_SB
#undef PG8_STAGE
#undef PG8_LDA
#undef PG8_LDB
#undef PG8_MMA
#undef PG8_WAIT_V
#undef PG8_WAIT_L
#undef PG8_BAR
#undef PG8_SCHED
}
}
typedef unsigned short bf16;
typedef short bf16x8 __attribute__((ext_vector_type(8)));
typedef float f32x4 __attribute__((ext_vector_type(4)));
typedef float f32x16 __attribute__((ext_vector_type(16)));
typedef unsigned u32x4 __attribute__((ext_vector_type(4)));
typedef unsigned u32x2 __attribute__((ext_vector_type(2)));
#define DI __device__ __forceinline__
#define LDS_WAIT() asm volatile("s_waitcnt lgkmcnt(0)" ::: "memory")

constexpr int MTOK = 32768;
constexpr size_t MiB = 1u << 20;
constexpr size_t WS_W = 2 * MiB, WS_ROWSQ = 42 * MiB;
constexpr size_t W_IN = WS_W, W_OUT = WS_W + 6 * MiB, W_GLU = WS_W + 8 * MiB, W_XQ = WS_W + 9 * MiB, W_XKV = WS_W + 11 * MiB, W_XO = WS_W + 15 * MiB, W_1 = WS_W + 17 * MiB, W_2 = WS_W + 25 * MiB;
constexpr size_t WS_MN = 35 * MiB, WS_DEC = 41 * MiB, WS_HN = 48 * MiB, WS_BIG = 112 * MiB;
constexpr size_t WS_XBB = WS_BIG + 192 * MiB;
constexpr size_t WS_KV = WS_BIG + 144 * MiB;
constexpr size_t WS_KVX = WS_BIG + 64 * MiB;
constexpr size_t WS_END = WS_BIG + 256 * MiB;
constexpr int LDS_BYTES = 135168;
constexpr float LOG2E = 1.4426950408889634f;

struct KArgs { const float* in[38]; float* out; unsigned char* ws; };
__device__ __forceinline__ const KArgs* kargs() { auto p = __builtin_amdgcn_kernarg_segment_ptr(); asm volatile("" : "+s"(p)); return (const KArgs*)p; }


DI float wave_sum(float v) {
#pragma unroll
    for (int o = 1; o < 64; o <<= 1) v += __shfl_xor(v, o);
    return v;
}
DI float wave_max(float v) {
#pragma unroll
    for (int o = 1; o < 64; o <<= 1) v = fmaxf(v, __shfl_xor(v, o));
    return v;
}
DI unsigned pk2(float lo, float hi) { return pg8::pk2e(lo, hi); }
DI float bflo(unsigned w) { return __uint_as_float(w << 16); }
DI float bfhi(unsigned w) { return __uint_as_float(w & 0xffff0000u); }
DI bf16 f2b(float f) { return (bf16)(pk2(f, 0.f) & 0xffffu); }
DI void unpack8(const u32x4 v, float* f) { f[0] = bflo(v.x); f[1] = bfhi(v.x); f[2] = bflo(v.y); f[3] = bfhi(v.y); f[4] = bflo(v.z); f[5] = bfhi(v.z); f[6] = bflo(v.w); f[7] = bfhi(v.w); }
DI u32x4 pack8u(const float* f) { u32x4 o; o.x = pk2(f[0], f[1]); o.y = pk2(f[2], f[3]); o.z = pk2(f[4], f[5]); o.w = pk2(f[6], f[7]); return o; }
DI f32x16 mfma32(bf16x8 a, bf16x8 b, f32x16 c) { return __builtin_amdgcn_mfma_f32_32x32x16_bf16(a, b, c, 0, 0, 0); }
DI f32x4 mfma16(bf16x8 a, bf16x8 b, f32x4 c) { return __builtin_amdgcn_mfma_f32_16x16x32_bf16(a, b, c, 0, 0, 0); }
DI int crow(int r, int hi) { return (r & 3) + 8 * (r >> 2) + 4 * hi; }

DI void transpose_item(const float* W, int K, int N, bf16* WT, float* scr, int item, int lane, const float* gain = nullptr, int qkperm = 0) {
    const int nblk = N / 32, kb = item / nblk, nb = item % nblk, k0 = 64 * kb, n0 = 32 * nb;
#pragma unroll 8
    for (int i = 0; i < 32; ++i) { const int kk = 2 * i + (lane >> 5); scr[kk * 33 + (lane & 31)] = W[(size_t)(k0 + kk) * N + n0 + (lane & 31)]; }
    LDS_WAIT();
    const int c = lane & 7;
    f32x4 g0 = (f32x4){1.f, 1.f, 1.f, 1.f}, g1 = g0;
    if (gain) { g0 = *(const f32x4*)(gain + k0 + 8 * c); g1 = *(const f32x4*)(gain + k0 + 8 * c + 4); }
#pragma unroll
    for (int j = 0; j < 4; ++j) { const int n = (lane >> 3) + 8 * j; const float* s = scr + (8 * c) * 33 + n;
        u32x4 o; o.x = pk2(s[0 * 33] * g0[0], s[1 * 33] * g0[1]); o.y = pk2(s[2 * 33] * g0[2], s[3 * 33] * g0[3]); o.z = pk2(s[4 * 33] * g1[0], s[5 * 33] * g1[1]); o.w = pk2(s[6 * 33] * g1[2], s[7 * 33] * g1[3]);
        const int cc = n0 + n; const int prow = (qkperm && cc < 2048) ? ((cc & ~255) + 128 * ((cc >> 5) & 1) + 32 * ((cc >> 6) & 3) + (cc & 31)) : cc;
        *(u32x4*)(WT + (size_t)prow * K + k0 + 8 * c) = o; }
    LDS_WAIT();
}
DI void convert_weights(int layer, unsigned char* lds) {
    const KArgs& a = *kargs();
    const int tid = otid(), lane = tid & 63, wave = tid >> 6;
    const int gw = obid() * 8 + wave, NGW = gridDim.x * 8;
    float* scr = (float*)(lds + wave * 8448);
    unsigned char* ws = a.ws;
    const bool even = !(layer & 1); const int hi = layer >> 1;
    const int nIn = even ? 16 * 65 : 16 * 96, nOut = 512, nGlu = even ? 128 : 0, nXq = 512, nXkv = 1024, nXo = 512, n1 = 2048, n2 = 2048;
    const int total = nIn + nOut + nGlu + nXq + nXkv + nXo + n1 + n2;
    for (int it = gw; it < total; it += NGW) {
        int r = it;
        if (r < nIn) { if (even) transpose_item(a.in[8] + (size_t)hi * 1024 * 2080, 1024, 2080, (bf16*)(ws + W_IN), scr, r, lane, a.in[4] + layer * 1024);
                       else transpose_item(a.in[22] + (size_t)hi * 1024 * 3072, 1024, 3072, (bf16*)(ws + W_IN), scr, r, lane, a.in[4] + layer * 1024, 1); continue; } r -= nIn;
        if (r < nOut) { transpose_item((even ? a.in[9] : a.in[23]) + (size_t)hi * 1024 * 1024, 1024, 1024, (bf16*)(ws + W_OUT), scr, r, lane); continue; } r -= nOut;
        if (r < nGlu) { transpose_item(a.in[18] + (size_t)hi * 512 * 512, 512, 512, (bf16*)(ws + W_GLU), scr, r, lane); continue; } r -= nGlu;
        if (r < nXq) { transpose_item(a.in[31] + (size_t)layer * 1024 * 1024, 1024, 1024, (bf16*)(ws + W_XQ), scr, r, lane, a.in[5] + layer * 1024); continue; } r -= nXq;
        if (r < nXkv) { transpose_item(a.in[32] + (size_t)layer * 1024 * 2048, 1024, 2048, (bf16*)(ws + W_XKV), scr, r, lane); continue; } r -= nXkv;
        if (r < nXo) { transpose_item(a.in[33] + (size_t)layer * 1024 * 1024, 1024, 1024, (bf16*)(ws + W_XO), scr, r, lane); continue; } r -= nXo;
        if (r < n1) { transpose_item(a.in[36] + (size_t)layer * 1024 * 4096, 1024, 4096, (bf16*)(ws + W_1), scr, r, lane, a.in[7] + layer * 1024); continue; } r -= n1;
        transpose_item(a.in[37] + (size_t)layer * 4096 * 1024, 4096, 1024, (bf16*)(ws + W_2), scr, r, lane);
    }
    if (even) {
        u32x4* z = (u32x4*)(ws + W_IN + (size_t)2080 * 1024 * 2); const int n16 = 224 * 1024 * 2 / 16;
        for (int i = obid() * 512 + tid; i < n16; i += gridDim.x * 512) z[i] = (u32x4){0u, 0u, 0u, 0u};
    }
}
template <bool COPY> DI void norm_rows(const float* src0, const float* src1, int split, int nrows, const float* gain, bf16* out, float* copy_dst) {
    const int tid = otid(), lane = tid & 63, wave = tid >> 6;
    const int gw = obid() * 8 + wave, NGW = gridDim.x * 8;
    f32x4 g[4];
#pragma unroll
    for (int j = 0; j < 4; ++j) g[j] = ((const f32x4*)gain)[lane + 64 * j];
    for (int m = gw; m < nrows; m += NGW) {
        const float* xr = (m < split) ? src0 + (size_t)m * 1024 : src1 + (size_t)(m - split) * 1024;
        f32x4 v[4]; float s = 0.f;
#pragma unroll
        for (int j = 0; j < 4; ++j) { v[j] = ((const f32x4*)xr)[lane + 64 * j]; s += (v[j].x * v[j].x + v[j].y * v[j].y) + (v[j].z * v[j].z + v[j].w * v[j].w); }
        const float rstd = 1.f / sqrtf(wave_sum(s) * (1.f / 1024.f) + 1e-6f);
        u32x2* o8 = (u32x2*)(out + (size_t)m * 1024);
#pragma unroll
        for (int j = 0; j < 4; ++j) { u32x2 w; w.x = pk2(v[j].x * rstd * g[j].x, v[j].y * rstd * g[j].y); w.y = pk2(v[j].z * rstd * g[j].z, v[j].w * rstd * g[j].w); o8[lane + 64 * j] = w;
            if (COPY) ((f32x4*)(copy_dst + (size_t)m * 1024))[lane + 64 * j] = v[j]; }
    }
}
DI void prep_rows(const float* src0, const float* src1, bf16* R, float* rsq) {
    const int tid = otid(), lane = tid & 63, wave = tid >> 6;
    const int gw = obid() * 8 + wave, NGW = gridDim.x * 8;
    for (int m = gw; m < MTOK; m += NGW) {
        const float* xr = (m < 16384) ? src0 + (size_t)m * 1024 : src1 + (size_t)(m - 16384) * 1024;
        float s = 0.f; u32x2* o8 = (u32x2*)(R + (size_t)m * 1024);
#pragma unroll
        for (int j = 0; j < 4; ++j) { const f32x4 v = ((const f32x4*)xr)[lane + 64 * j]; u32x2 w; w.x = pk2(v.x, v.y); w.y = pk2(v.z, v.w); o8[lane + 64 * j] = w;
            const float a0 = bflo(w.x), a1 = bfhi(w.x), a2 = bflo(w.y), a3 = bfhi(w.y); s += (a0 * a0 + a1 * a1) + (a2 * a2 + a3 * a3); }
        s = wave_sum(s);
        if (lane < 16) rsq[(size_t)m * 16 + lane] = lane == 0 ? s : 0.f;
    }
}
DI void segnorm(bf16* buf, int ld, int rows, int nchunks, int W, const float* gainA, float scaleA, int chunksA, const float* gainB, float scaleB) {
    const int tid = otid(), lane = tid & 63, wave = tid >> 6;
    const int gw = obid() * 8 + wave, NGW = gridDim.x * 8;
    const int total = rows * nchunks, gi = (lane * 8) % W; const float invW = 1.f / (float)W; const int lim = W / 8;
    for (int it = gw; it < total; it += NGW) {
        const int row = it / nchunks, ch = it % nchunks;
        bf16* p = buf + (size_t)row * ld + ch * 512 + lane * 8;
        const u32x4 v = *(const u32x4*)p; float f[8]; unpack8(v, f);
        float s = 0.f;
#pragma unroll
        for (int i = 0; i < 8; ++i) s += f[i] * f[i];
        for (int o = 1; o < lim; o <<= 1) s += __shfl_xor(s, o);
        const float rstd = 1.f / sqrtf(s * invW + 1e-6f);
        const float* g = (ch < chunksA) ? gainA : gainB; const float sc = ((ch < chunksA) ? scaleA : scaleB) * rstd;
#pragma unroll
        for (int i = 0; i < 8; ++i) f[i] = f[i] * sc * g[gi + i];
        *(u32x4*)p = pack8u(f);
    }
}
template <int M, int N, int K, int LDA, class Epi> DI void run_gemm(unsigned char* lds, const bf16* A, const bf16* Bt, const Epi& E) {
    constexpr int lda = LDA;
    pg8::Gemm g{A, lda, Bt, M, N, K}; pg8::StaticOrder S; S.init(M, N, (int)gridDim.x, obid());
    pg8::gemm_phase<Epi, pg8::StaticOrder, true, true>((PG8_LAS unsigned char*)lds, g, S, E);
}
#define S5_FENCE() asm volatile("" ::: "memory")
DI float fma_s(float a, float b, float c) { float d; asm("v_fma_f32 %0, %1, %2, %3" : "=v"(d) : "v"(a), "v"(b), "v"(c)); return d; }
DI void s5_phase(int e, unsigned char* lds, const bf16* proj, bf16* yf, bf16* yb) {
    const KArgs& a = *kargs();
    const int tid = otid(), lane = tid & 63, wave = tid >> 6, l31 = lane & 31, hi = lane >> 5; const int G = gridDim.x;
    float* BUf = (float*)(lds + wave * 27136); unsigned char* sb = lds + wave * 27136 + 18432;
    if (wave < 4) for (int t = wave * G + obid(); t < 768; t += 4 * G) {
        int seq, rem, L, rowbase;
        if (t < 256) { seq = t >> 6; rem = t & 63; L = 4096; rowbase = seq * 4096; }
        else { const int t2 = t - 256; seq = t2 >> 6; rem = t2 & 63; L = 2048; rowbase = 16384 + seq * 2048; }
        const int g = rem >> 1, dir = rem & 1;
        const int pd = (e * 2 + dir) * 32 + g;
        const float stp = expf(a.in[12][pd]);
        float lbr, lbi;
        { const float lr = a.in[10][pd * 64 + lane], li = a.in[11][pd * 64 + lane]; const float mag = expf(lr * stp); float sn, cs; sincosf(li * stp, &sn, &cs); lbr = mag * cs; lbi = mag * sn; }
        bf16x8 bfr[4];
#pragma unroll
        for (int nb = 0; nb < 4; ++nb) { const int col = 32 * nb + l31, p = col >> 1, ri = col & 1;
            const float lr = a.in[10][pd * 64 + p], li = a.in[11][pd * 64 + p]; const float mag = expf(lr * stp); float sn, cs; sincosf(li * stp, &sn, &cs);
            const float nr0 = mag * cs - 1.f, ni0 = mag * sn, den = lr * lr + li * li;
            const float cr = (nr0 * lr + ni0 * li) / den, ci = (ni0 * lr - nr0 * li) / den;
            const f32x4* br4 = (const f32x4*)(a.in[13] + ((size_t)pd * 64 + p) * 16 + 8 * hi); const f32x4* bi4 = (const f32x4*)(a.in[14] + ((size_t)pd * 64 + p) * 16 + 8 * hi);
            float f[8];
#pragma unroll
            for (int q = 0; q < 2; ++q) { const f32x4 x = br4[q], y = bi4[q];
#pragma unroll
                for (int i = 0; i < 4; ++i) f[4 * q + i] = ri ? (cr * y[i] + ci * x[i]) : (cr * x[i] - ci * y[i]); }
            bfr[nb] = __builtin_bit_cast(bf16x8, pack8u(f)); }
        bf16x8 cf[4];
        { const int c = lane & 15, kq = lane >> 4; const float* cre = a.in[15] + ((size_t)pd * 16 + c) * 64; const float* cim = a.in[16] + ((size_t)pd * 16 + c) * 64;
#pragma unroll
          for (int s = 0; s < 4; ++s) { float f[8];
#pragma unroll
              for (int j = 0; j < 4; ++j) { const int pp = 16 * s + 4 * kq + j; f[2 * j] = cre[pp]; f[2 * j + 1] = -cim[pp]; }
              cf[s] = __builtin_bit_cast(bf16x8, pack8u(f)); } }
        float sr = 0.f, si = 0.f; const float nlbi = -lbi;
        const int NC = L / 32;
        bf16* ydst = dir ? yb : yf;
        const bf16* ubase = proj + (size_t)(rowbase + l31) * 2304 + g * 16 + 8 * hi;
        bf16x8 ua = *(const bf16x8*)(ubase + (size_t)((dir ? NC - 1 : 0) * 32) * 2304);
        bf16x8 ub = ua; if (NC > 1) ub = *(const bf16x8*)(ubase + (size_t)((dir ? NC - 2 : 1) * 32) * 2304);
        for (int ci2 = 0; ci2 < NC; ++ci2) {
            const int c = dir ? NC - 1 - ci2 : ci2; const int t0 = c * 32;
#pragma unroll
            for (int nb = 0; nb < 4; ++nb) { const f32x16 d = mfma32(ua, bfr[nb], f32x16{});
#pragma unroll
                for (int j = 0; j < 4; ++j) *(f32x4*)(BUf + (32 * nb + l31) * 36 + 8 * j + 4 * hi) = (f32x4){d[4 * j], d[4 * j + 1], d[4 * j + 2], d[4 * j + 3]}; }
            S5_FENCE();
            ua = ub; if (ci2 + 2 < NC) { const int cn = dir ? c - 2 : c + 2; ub = *(const bf16x8*)(ubase + (size_t)(cn * 32) * 2304); }
            typedef float f32x2s __attribute__((ext_vector_type(2)));
            f32x2s bu[32];
#pragma unroll
            for (int q = 0; q < 8; ++q) { const f32x4 re4 = *(const f32x4*)(BUf + (2 * lane) * 36 + 4 * q), im4 = *(const f32x4*)(BUf + (2 * lane + 1) * 36 + 4 * q);
#pragma unroll
                for (int i = 0; i < 4; ++i) { bu[4 * q + i].x = re4[i]; bu[4 * q + i].y = im4[i]; } }
            S5_FENCE();
            if (dir == 0) {
#pragma unroll
                for (int k = 0; k < 32; ++k) { const float nr = fma_s(lbr, sr, fma_s(nlbi, si, bu[k].x)), ni = fma_s(lbr, si, fma_s(lbi, sr, bu[k].y)); sr = nr; si = ni; *(unsigned*)(sb + k * 272 + lane * 4) = pk2(sr, si); }
            } else {
#pragma unroll
                for (int k = 31; k >= 0; --k) { const float nr = fma_s(lbr, sr, fma_s(nlbi, si, bu[k].x)), ni = fma_s(lbr, si, fma_s(lbi, sr, bu[k].y)); sr = nr; si = ni; *(unsigned*)(sb + k * 272 + lane * 4) = pk2(sr, si); }
            }
            S5_FENCE();
#pragma unroll
            for (int mt = 0; mt < 2; ++mt) { f32x4 acc = (f32x4){0.f, 0.f, 0.f, 0.f};
#pragma unroll
                for (int s = 0; s < 4; ++s) { const bf16x8 av = *(const bf16x8*)(sb + (16 * mt + (lane & 15)) * 272 + (32 * s + 8 * (lane >> 4)) * 2); acc = mfma16(av, cf[s], acc); }
#pragma unroll
                for (int i = 0; i < 4; ++i) ydst[(size_t)(rowbase + t0 + 16 * mt + 4 * (lane >> 4) + i) * 512 + g * 16 + (lane & 15)] = f2b(acc[i]); }
            S5_FENCE();
        }
    }
}
DI void s5_combine(int e, bf16* proj, const bf16* yf, const bf16* yb) {
    const KArgs& a = *kargs();
    const int gid = obid() * 512 + otid(), stride = gridDim.x * 512;
    for (int it = gid; it < MTOK * 64; it += stride) {
        const int row = it >> 6, c8 = (it & 63) * 8;
        const u32x4 vf = *(const u32x4*)(yf + (size_t)row * 512 + c8), vb = *(const u32x4*)(yb + (size_t)row * 512 + c8);
        bf16* up = proj + (size_t)row * 2304 + c8; const u32x4 vu = *(const u32x4*)up;
        float f[8], b[8], u[8]; unpack8(vf, f); unpack8(vb, b); unpack8(vu, u);
        const f32x4 d0 = *(const f32x4*)(a.in[17] + e * 512 + c8), d1 = *(const f32x4*)(a.in[17] + e * 512 + c8 + 4);
#pragma unroll
        for (int i = 0; i < 8; ++i) { const float dd = i < 4 ? d0[i] : d1[i - 4]; const float y = f[i] + b[i] + dd * u[i];
            const float z = 0.7978845608028654f * (y + 0.044715f * y * y * y); const float th = 1.f - 2.f / (1.f + __expf(2.f * z)); f[i] = 0.5f * y * (1.f + th); }
        *(u32x4*)up = pack8u(f);
    }
}
constexpr int GL_CUM = 0, GL_SEGT = 33280, GL_GLR = 35328, GL_VT = 43520, GL_A = 61952, GL_B = 80384, GL_C = 98816, GL_RS = 117248, CS = 65;
DI float logsig(float x) { return fminf(x, 0.f) - __logf(1.f + __expf(-fabsf(x))); }
DI void gla_cumsum(int e, int h, unsigned char* lds, const u32x2 glr_pre) {
    const KArgs& a = *kargs();
    const int tid = otid();
    float* cumS = (float*)(lds + GL_CUM); float* glrS = (float*)(lds + GL_GLR); float* segT = (float*)(lds + GL_SEGT);
    { const int r = tid >> 3, c4 = (tid & 7) * 4; const u32x2 v = glr_pre;
      *(f32x4*)(glrS + r * 32 + c4) = (f32x4){bflo(v.x), bfhi(v.x), bflo(v.y), bfhi(v.y)}; }
    __syncthreads();
    const int z = tid >> 8, seg = (tid >> 6) & 3, d = tid & 63;
    float c[16];
    { float w[16];
#pragma unroll
      for (int r = 0; r < 16; ++r) w[r] = a.in[19][((size_t)(e * 2 + z) * 16 + r) * 256 + h * 64 + d];
      const float b = a.in[20][(e * 2 + z) * 256 + h * 64 + d]; float cum = 0.f;
#pragma unroll
      for (int k = 0; k < 16; ++k) { const int t = z ? 16 * seg + 15 - k : 16 * seg + k; const f32x4* lr4 = (const f32x4*)(glrS + t * 32 + z * 16); float lg = b;
#pragma unroll
          for (int q = 0; q < 4; ++q) { const f32x4 x = lr4[q]; lg += x[0] * w[4 * q] + x[1] * w[4 * q + 1] + x[2] * w[4 * q + 2] + x[3] * w[4 * q + 3]; }
          cum += logsig(lg) * (1.f / 16.f); c[k] = cum; }
      segT[(z * 4 + seg) * 64 + d] = cum; }
    __syncthreads();
    { float pre = 0.f;
#pragma unroll
      for (int s2 = 0; s2 < 4; ++s2) { const bool before = z ? (s2 > seg) : (s2 < seg); const float v = segT[(z * 4 + s2) * 64 + d]; pre += before ? v : 0.f; }
#pragma unroll
      for (int k = 0; k < 16; ++k) { const int t = z ? 16 * seg + 15 - k : 16 * seg + k; cumS[(z * 64 + t) * CS + d] = c[k] + pre; } }
    __syncthreads();
}
DI void gla_stage_vt(unsigned char* lds, const u32x4 v0, const u32x4 v1) {
    const int tid = otid(), j = tid & 63, ec = (tid >> 6) * 16; bf16* Vt = (bf16*)(lds + GL_VT);
    const unsigned w[8] = {v0.x, v0.y, v0.z, v0.w, v1.x, v1.y, v1.z, v1.w};
#pragma unroll
    for (int i = 0; i < 8; ++i) { Vt[(ec + 2 * i) * 72 + j] = (bf16)(w[i] & 0xffffu); Vt[(ec + 2 * i + 1) * 72 + j] = (bf16)(w[i] >> 16); }
}
DI void gla_g1(int e, unsigned char* lds, const bf16* proj, bf16* kvbuf, float* dec) {
    const KArgs& a = *kargs();
    const int tid = otid(), lane = tid & 63, wave = tid >> 6, l31 = lane & 31, hi = lane >> 5;
    const float* cumS = (const float*)(lds + GL_CUM); bf16* Vt = (bf16*)(lds + GL_VT); bf16* KoT = (bf16*)(lds + GL_A);
#define GLA_PRE(T_, GL_, K_, V0_, V1_) do { const int n_ = (T_) >> 2, h_ = (T_) & 3; const bf16* rb_ = proj + (size_t)(n_ * 64) * 2304; \
        GL_ = *(const u32x2*)(rb_ + (size_t)(tid >> 3) * 2304 + 2048 + (tid & 7) * 4); K_ = *(const u32x4*)(rb_ + (size_t)(tid & 63) * 2304 + 768 + h_ * 64 + (tid >> 6) * 8); \
        const bf16* vp_ = rb_ + (size_t)(tid & 63) * 2304 + 1024 + h_ * 128 + (tid >> 6) * 16; V0_ = *(const u32x4*)vp_; V1_ = *(const u32x4*)(vp_ + 8); } while (0)
    u32x2 nglr = (u32x2){0u, 0u}; u32x4 nk = (u32x4){0u, 0u, 0u, 0u}, nv0 = nk, nv1 = nk;
    if (obid() < 2048) GLA_PRE(obid(), nglr, nk, nv0, nv1);
    for (int task = obid(); task < 2048; task += gridDim.x) {
        const int n = task >> 2, h = task & 3, row0 = n * 64; (void)row0; (void)n;
        const u32x2 cglr = nglr; const u32x4 kv = nk, cv0 = nv0, cv1 = nv1;
        if (task + (int)gridDim.x < 2048) GLA_PRE(task + (int)gridDim.x, nglr, nk, nv0, nv1);
        gla_cumsum(e, h, lds, cglr);
        { const int j = tid & 63, dc = (tid >> 6) * 8; float kf[8]; unpack8(kv, kf);
#pragma unroll
          for (int z = 0; z < 2; ++z)
#pragma unroll
              for (int i = 0; i < 8; ++i) { const int d = dc + i; const float tot = cumS[(z * 64 + (z ? 0 : 63)) * CS + d];
                  KoT[(z * 64 + d) * 72 + j] = f2b(kf[i] * __expf(tot - cumS[(z * 64 + j) * CS + d])); } }
        gla_stage_vt(lds, cv0, cv1);
        __syncthreads();
        { const int z = wave >> 2, eb = wave & 3; f32x16 acc[2]; acc[0] = f32x16{}; acc[1] = f32x16{};
#pragma unroll
          for (int s = 0; s < 4; ++s) { const bf16x8 av = *(const bf16x8*)(Vt + (32 * eb + l31) * 72 + 16 * s + 8 * hi);
#pragma unroll
              for (int nb = 0; nb < 2; ++nb) { const bf16x8 bv = *(const bf16x8*)(KoT + (z * 64 + 32 * nb + l31) * 72 + 16 * s + 8 * hi); acc[nb] = mfma32(av, bv, acc[nb]); } }
          bf16* dst = kvbuf + ((size_t)(task * 2 + z) * 128 + 32 * eb) * 64 + l31;
#pragma unroll
          for (int nb = 0; nb < 2; ++nb)
#pragma unroll
              for (int r = 0; r < 16; ++r) dst[crow(r, hi) * 64 + 32 * nb] = f2b(acc[nb][r]); }
        if (tid < 128) { const int z = tid >> 6, d = tid & 63; dec[(size_t)(task * 2 + z) * 64 + d] = __expf(cumS[(z * 64 + (z ? 0 : 63)) * CS + d]); }
        __syncthreads();
    }
}
DI void gla_g2(bf16* kvbuf, const float* dec) {
    const int gid = obid() * 512 + otid(), stride = gridDim.x * 512;
    for (int it = gid; it < 98304; it += stride) {
        const int dc = it & 7, ee = (it >> 3) & 127, z = (it >> 10) & 1, sh = it >> 11, seq = sh >> 2, h = sh & 3;
        const int chunk0 = seq < 4 ? seq * 64 : 256 + (seq - 4) * 32, NC = seq < 4 ? 64 : 32;
        float S[8];
#pragma unroll
        for (int i = 0; i < 8; ++i) S[i] = 0.f;
        for (int ci = 0; ci < NC; ++ci) { const int c = z ? NC - 1 - ci : ci; const int task = (chunk0 + c) * 4 + h;
            bf16* p = kvbuf + ((size_t)(task * 2 + z) * 128 + ee) * 64 + dc * 8; const u32x4 kvv = *(const u32x4*)p; float kv[8]; unpack8(kvv, kv);
            const float* dp = dec + (size_t)(task * 2 + z) * 64 + dc * 8; const f32x4 d0 = *(const f32x4*)dp, d1 = *(const f32x4*)(dp + 4);
            *(u32x4*)p = pack8u(S);
#pragma unroll
            for (int i = 0; i < 8; ++i) S[i] = (i < 4 ? d0[i] : d1[i - 4]) * S[i] + kv[i]; }
    }
}
DI void gla_g3(int e, unsigned char* lds, const bf16* proj, const bf16* kvbuf, bf16* ycat) {
    const KArgs& a = *kargs();
    const int tid = otid(), lane = tid & 63, wave = tid >> 6, l31 = lane & 31, hi = lane >> 5;
    const float* cumS = (const float*)(lds + GL_CUM); bf16* Vt = (bf16*)(lds + GL_VT);
    bf16* Qrel = (bf16*)(lds + GL_A); bf16* Krel = (bf16*)(lds + GL_B); bf16* Qd = (bf16*)(lds + GL_C); float* rs = (float*)(lds + GL_RS);
#define GLA_PRE3(T_, GL_, Q_, K_, V0_, V1_) do { const int n_ = (T_) >> 2, h_ = (T_) & 3; const bf16* rb_ = proj + (size_t)(n_ * 64) * 2304; \
        GL_ = *(const u32x2*)(rb_ + (size_t)(tid >> 3) * 2304 + 2048 + (tid & 7) * 4); const bf16* rp_ = rb_ + (size_t)(tid >> 3) * 2304 + h_ * 64 + (tid & 7) * 8; Q_ = *(const u32x4*)(rp_ + 512); K_ = *(const u32x4*)(rp_ + 768); \
        const bf16* vp_ = rb_ + (size_t)(tid & 63) * 2304 + 1024 + h_ * 128 + (tid >> 6) * 16; V0_ = *(const u32x4*)vp_; V1_ = *(const u32x4*)(vp_ + 8); } while (0)
    u32x2 nglr = (u32x2){0u, 0u}; u32x4 nq = (u32x4){0u, 0u, 0u, 0u}, nk = nq, nv0 = nq, nv1 = nq;
    if (obid() < 2048) GLA_PRE3(obid(), nglr, nq, nk, nv0, nv1);
    for (int task = obid(); task < 2048; task += gridDim.x) {
        const int n = task >> 2, h = task & 3, row0 = n * 64;
        const u32x2 cglr = nglr; const u32x4 qv = nq, kv = nk, cv0 = nv0, cv1 = nv1;
        if (task + (int)gridDim.x < 2048) GLA_PRE3(task + (int)gridDim.x, nglr, nq, nk, nv0, nv1);
        gla_cumsum(e, h, lds, cglr);
        { const int j = tid >> 3, dc = (tid & 7) * 8;
          float qf[8], kf[8]; unpack8(qv, qf); unpack8(kv, kf);
#pragma unroll
          for (int z = 0; z < 2; ++z) { float o1[8], o2[8], o3[8];
#pragma unroll
              for (int i = 0; i < 8; ++i) { const int d = dc + i; const float cj = cumS[(z * 64 + j) * CS + d], rf = cumS[(z * 64 + (z ? 32 : 31)) * CS + d]; const float q8 = qf[i] * 0.125f;
                  o1[i] = q8 * __expf(cj - rf); o2[i] = kf[i] * __expf(rf - cj); o3[i] = q8 * __expf(cj); }
              *(u32x4*)(Qrel + (z * 64 + j) * 72 + dc) = pack8u(o1); *(u32x4*)(Krel + (z * 64 + j) * 72 + dc) = pack8u(o2); *(u32x4*)(Qd + (z * 64 + j) * 72 + dc) = pack8u(o3); } }
        gla_stage_vt(lds, cv0, cv1);
        const int ib = wave >> 2, eb = wave & 3; f32x16 acc = f32x16{};
        bf16x8 bsr[2][4];
#pragma unroll
        for (int z = 0; z < 2; ++z)
#pragma unroll
            for (int s = 0; s < 4; ++s) bsr[z][s] = *(const bf16x8*)(kvbuf + ((size_t)(task * 2 + z) * 128 + 32 * eb + l31) * 64 + 16 * s + 8 * hi);
        unsigned short ogr[16];
#pragma unroll
        for (int r = 0; r < 16; ++r) ogr[r] = proj[(size_t)(row0 + 32 * ib + crow(r, hi)) * 2304 + 1536 + h * 128 + 32 * eb + l31];
        __syncthreads();
#pragma unroll
        for (int z = 0; z < 2; ++z) {
            f32x16 st[2]; st[0] = f32x16{}; st[1] = f32x16{};
#pragma unroll
            for (int s = 0; s < 4; ++s) { const bf16x8 bq = *(const bf16x8*)(Qrel + (z * 64 + 32 * ib + l31) * 72 + 16 * s + 8 * hi);
#pragma unroll
                for (int jb = 0; jb < 2; ++jb) { const bf16x8 ak = *(const bf16x8*)(Krel + (z * 64 + 32 * jb + l31) * 72 + 16 * s + 8 * hi); st[jb] = mfma32(ak, bq, st[jb]); } }
            const int i = 32 * ib + l31;
#pragma unroll
            for (int jb = 0; jb < 2; ++jb)
#pragma unroll
                for (int r = 0; r < 16; ++r) { const int j = 32 * jb + crow(r, hi); const bool keep = z ? (j >= i) : (j <= i); st[jb][r] = keep ? st[jb][r] : 0.f; }
#pragma unroll
            for (int jb = 0; jb < 2; ++jb)
#pragma unroll
                for (int s2 = 0; s2 < 2; ++s2) { float pf[8];
#pragma unroll
                    for (int q = 0; q < 8; ++q) pf[q] = st[jb][8 * s2 + q];
                    const bf16* vp = Vt + (32 * eb + l31) * 72 + 32 * jb + 16 * s2 + 4 * hi; const u32x2 lo = *(const u32x2*)vp, hi8 = *(const u32x2*)(vp + 8);
                    const u32x4 bw = (u32x4){lo.x, lo.y, hi8.x, hi8.y};
                    acc = mfma32(__builtin_bit_cast(bf16x8, pack8u(pf)), __builtin_bit_cast(bf16x8, bw), acc); }
#pragma unroll
            for (int s = 0; s < 4; ++s) { const bf16x8 aq = *(const bf16x8*)(Qd + (z * 64 + 32 * ib + l31) * 72 + 16 * s + 8 * hi);
                acc = mfma32(aq, bsr[z][s], acc); }
        }
        float sq[16];
#pragma unroll
        for (int r = 0; r < 16; ++r) { float v = acc[r] * acc[r]; v += __shfl_xor(v, 1); v += __shfl_xor(v, 2); v += __shfl_xor(v, 4); v += __shfl_xor(v, 8); v += __shfl_xor(v, 16); sq[r] = v; }
        if (l31 == 0) {
#pragma unroll
            for (int r = 0; r < 16; ++r) rs[wave * 32 + crow(r, hi)] = sq[r]; }
        __syncthreads();
        { const int ecol = h * 128 + 32 * eb + l31; const float gn = a.in[21][e * 128 + 32 * eb + l31];
#pragma unroll
          for (int r = 0; r < 16; ++r) { const int il = crow(r, hi); const float tot = rs[(ib * 4 + 0) * 32 + il] + rs[(ib * 4 + 1) * 32 + il] + rs[(ib * 4 + 2) * 32 + il] + rs[(ib * 4 + 3) * 32 + il];
              const float rstd = 1.f / sqrtf(tot * (1.f / 128.f) + 1e-6f); const size_t row = (size_t)(row0 + 32 * ib + il);
              const float og = bflo((unsigned)ogr[r]); const float sl = og / (1.f + __expf(-og));
              ycat[row * 1024 + 512 + ecol] = f2b(acc[r] * rstd * gn * sl); } }
        __syncthreads();
    }
}
template <bool DIFF>
DI void attn_unit(unsigned char* lds, const bf16* Qb, int ldq, const bf16* Kb, int ldk, const bf16* Vb, int ldv, int nkeys,
                  bf16* Ob, int ldo, int qpos0, float slope2, float negSB2, float lam, const float* sub_gain, float outscale) {
    constexpr int DK = DIFF ? 64 : 256, KW = DIFF ? 128 : 256, DVT = DIFF ? 128 : 256, KS = KW + 8, VS = 72, NS = DK / 16;
    constexpr int KCH = KW / 8, VCH = DVT / 8, NKL = 64 * KCH / 512, NVL = 64 * VCH / 512;
    bf16* Ks = (bf16*)lds; bf16* Vt = (bf16*)(lds + 34816); float* EX = (float*)lds;
    const int tid = otid(), lane = tid & 63, wave = tid >> 6, l31 = lane & 31, hi = lane >> 5, qg = wave & 3, sel = wave >> 2;
    const int kcol = DIFF ? sel * 64 : 0, vrow0 = DIFF ? 0 : sel * 128;
    bf16x8 qf[NS];
    { const bf16* qp = Qb + (size_t)(qg * 32 + l31) * ldq + kcol + 8 * hi;
#pragma unroll
      for (int s = 0; s < NS; ++s) qf[s] = *(const bf16x8*)(qp + 16 * s); }
    f32x16 O[4];
#pragma unroll
    for (int nb = 0; nb < 4; ++nb) O[nb] = f32x16{};
    float lsum = 0.f;
    const int NT = nkeys / 64;
    const float qposf = (float)(qpos0 + qg * 32 + l31);
    u32x4 kreg[NKL], vreg[NVL];
#define ATT_LOAD(t) do { \
    _Pragma("unroll") for (int i_ = 0; i_ < NKL; ++i_) { const int c_ = tid + i_ * 512, row_ = c_ / KCH, cc_ = c_ % KCH; kreg[i_] = *(const u32x4*)(Kb + (size_t)((t) * 64 + row_) * ldk + cc_ * 8); } \
    _Pragma("unroll") for (int i_ = 0; i_ < NVL; ++i_) { const int c_ = tid + i_ * 512, row_ = c_ / VCH, cc_ = c_ % VCH; vreg[i_] = *(const u32x4*)(Vb + (size_t)((t) * 64 + row_) * ldv + cc_ * 8); } } while (0)
    if (DIFF) ATT_LOAD(0);
    for (int t = 0; t < NT; ++t) {
        if (!DIFF) ATT_LOAD(t);
#pragma unroll
        for (int i = 0; i < NKL; ++i) { const int c = tid + i * 512, row = c / KCH, cc = c % KCH; *(u32x4*)(Ks + row * KS + cc * 8) = kreg[i]; }
#pragma unroll
        for (int i = 0; i < NVL; ++i) { const int c = tid + i * 512, row = c / VCH, cc = c % VCH; const unsigned w[4] = {vreg[i].x, vreg[i].y, vreg[i].z, vreg[i].w};
#pragma unroll
            for (int q = 0; q < 4; ++q) { Vt[(cc * 8 + 2 * q) * VS + row] = (bf16)(w[q] & 0xffffu); Vt[(cc * 8 + 2 * q + 1) * VS + row] = (bf16)(w[q] >> 16); } }
        __syncthreads();
        if (DIFF && t + 1 < NT) ATT_LOAD(t + 1);
        f32x16 st[2];
#pragma unroll
        for (int r = 0; r < 16; ++r) { st[0][r] = negSB2; st[1][r] = negSB2; }
#pragma unroll
        for (int s = 0; s < NS; ++s)
#pragma unroll
            for (int kb = 0; kb < 2; ++kb) { const bf16x8 av = *(const bf16x8*)(Ks + (32 * kb + l31) * KS + kcol + 16 * s + 8 * hi); st[kb] = mfma32(av, qf[s], st[kb]); }
        bf16x8 pf[2][2];
#pragma unroll
        for (int kb = 0; kb < 2; ++kb) {
            const float base = qposf - (float)(t * 64 + 32 * kb + 4 * hi);
            float p[16];
#pragma unroll
            for (int r = 0; r < 16; ++r) { float x = st[kb][r];
                if (DIFF) { const float dl = base - (float)((r & 3) + 8 * (r >> 2)); x = x - slope2 * fabsf(dl); }
                p[r] = __builtin_amdgcn_exp2f(x); lsum += p[r]; }
            pf[kb][0] = __builtin_bit_cast(bf16x8, pack8u(p)); pf[kb][1] = __builtin_bit_cast(bf16x8, pack8u(p + 8));
        }
#pragma unroll
        for (int nb = 0; nb < 4; ++nb)
#pragma unroll
            for (int kb = 0; kb < 2; ++kb)
#pragma unroll
                for (int s2 = 0; s2 < 2; ++s2) { const bf16* vp = Vt + (vrow0 + 32 * nb + l31) * VS + 32 * kb + 16 * s2 + 4 * hi; const u32x2 lo = *(const u32x2*)vp, hi8 = *(const u32x2*)(vp + 8);
                    const u32x4 bw = (u32x4){lo.x, lo.y, hi8.x, hi8.y}; O[nb] = mfma32(pf[kb][s2], __builtin_bit_cast(bf16x8, bw), O[nb]); }
        __syncthreads();
    }
#undef ATT_LOAD
    lsum += __shfl_xor(lsum, 32);
    float invl[16];
#pragma unroll
    for (int r = 0; r < 16; ++r) invl[r] = 1.f / __shfl(lsum, crow(r, hi));
#pragma unroll
    for (int nb = 0; nb < 4; ++nb)
#pragma unroll
        for (int r = 0; r < 16; ++r) O[nb][r] *= invl[r];
    if (DIFF) {
        if (sel == 1) {
#pragma unroll
            for (int nb = 0; nb < 4; ++nb)
#pragma unroll
                for (int r = 0; r < 16; ++r) EX[((qg * 4 + nb) * 16 + r) * 64 + lane] = O[nb][r]; }
        __syncthreads();
        if (sel == 0) {
            float sq[16];
#pragma unroll
            for (int r = 0; r < 16; ++r) sq[r] = 0.f;
#pragma unroll
            for (int nb = 0; nb < 4; ++nb)
#pragma unroll
                for (int r = 0; r < 16; ++r) { const float v = O[nb][r] - lam * EX[((qg * 4 + nb) * 16 + r) * 64 + lane]; O[nb][r] = v; sq[r] += v * v; }
#pragma unroll
            for (int r = 0; r < 16; ++r) { float v = sq[r]; v += __shfl_xor(v, 1); v += __shfl_xor(v, 2); v += __shfl_xor(v, 4); v += __shfl_xor(v, 8); v += __shfl_xor(v, 16);
                sq[r] = outscale / sqrtf(v * (1.f / 128.f) + 1e-6f); }
#pragma unroll
            for (int nb = 0; nb < 4; ++nb) { const float gn = sub_gain[32 * nb + l31];
#pragma unroll
                for (int r = 0; r < 16; ++r) Ob[(size_t)(qg * 32 + crow(r, hi)) * ldo + 32 * nb + l31] = f2b(O[nb][r] * sq[r] * gn); }
        }
        __syncthreads();
    } else {
#pragma unroll
        for (int nb = 0; nb < 4; ++nb)
#pragma unroll
            for (int r = 0; r < 16; ++r) Ob[(size_t)(qg * 32 + crow(r, hi)) * ldo + sel * 128 + 32 * nb + l31] = f2b(O[nb][r]);
    }
}
DI void diff_attn_phase(int o, int layer, unsigned char* lds, bf16* QKV, bf16* dummyO) {
    const KArgs& a = *kargs();
    const int lane = otid() & 63;
    const float gq = wave_max(fabsf(a.in[24][o * 64 + lane])), gk = wave_max(fabsf(a.in[25][o * 64 + lane]));
    const float negSB2 = -(8.f * gq * gk * 1.02f + 0.5f) * LOG2E;
    const float d1 = wave_sum(a.in[26][o * 64 + lane] * a.in[27][o * 64 + lane]), d2 = wave_sum(a.in[28][o * 64 + lane] * a.in[29][o * 64 + lane]);
    const float lambda_init = 0.8f - 0.6f * expf(-0.3f * (float)layer);
    const float lam = expf(d1) - expf(d2) + lambda_init;
    for (int u = obid(); u < 2048; u += gridDim.x) {
        int head, qb, L, rowbase;
        if (u < 1024) { const int seq = u >> 8, rem = u & 255; head = rem >> 5; qb = rem & 31; L = 4096; rowbase = seq * 4096; }
        else { const int u2 = u - 1024, seq = u2 >> 7, rem = u2 & 127; head = rem >> 4; qb = rem & 15; L = 2048; rowbase = 16384 + seq * 2048; }
        bf16* Qb = QKV + (size_t)(rowbase + qb * 128) * 3072 + head * 128;
        const bf16* Kb = QKV + (size_t)rowbase * 3072 + 1024 + head * 128; const bf16* Vb = QKV + (size_t)rowbase * 3072 + 2048 + head * 128;
        const float slope2 = exp2f(-(float)(head + 1)) * LOG2E;
        bf16* Od = dummyO ? dummyO + (size_t)(rowbase + qb * 128) * 1024 + head * 128 : Qb;
        attn_unit<true>(lds, Qb, 3072, Kb, 3072, Vb, 3072, L, Od, dummyO ? 1024 : 3072, qb * 128, slope2, negSB2, lam, a.in[30] + o * 128, 1.f - lambda_init);
    }
}
DI void cross_attn_phase(int layer, unsigned char* lds, bf16* qx, const bf16* kvx, bf16* dummyO) {
    const KArgs& a = *kargs();
    const int lane = otid() & 63;
    float gq = 0.f, gk = 0.f;
#pragma unroll
    for (int i = 0; i < 4; ++i) { gq = fmaxf(gq, fabsf(a.in[34][layer * 256 + lane + 64 * i])); gk = fmaxf(gk, fabsf(a.in[35][layer * 256 + lane + 64 * i])); }
    gq = wave_max(gq); gk = wave_max(gk);
    const float negSB2 = -(16.f * gq * gk * 1.02f + 0.5f) * LOG2E;
    for (int u = obid(); u < 1024; u += gridDim.x) {
        const int rb = u >> 2, head = u & 3, row0 = rb * 128; const int seq = row0 < 16384 ? (row0 >> 12) : 4 + ((row0 - 16384) >> 11);
        bf16* Qb = qx + (size_t)row0 * 1024 + head * 256; const bf16* Kb = kvx + (size_t)(seq * 256) * 2048 + head * 256; const bf16* Vb = Kb + 1024;
        bf16* Od = dummyO ? dummyO + (size_t)row0 * 1024 + head * 256 : Qb;
        attn_unit<false>(lds, Qb, 1024, Kb, 2048, Vb, 2048, 256, Od, 1024, 0, 0.f, negSB2, 0.f, nullptr, 1.f);
    }
}
DI void vt_prep(unsigned char* lds, const bf16* QKV, bf16* VT) {
    const int tid = otid(); bf16* T = (bf16*)lds;
    for (int item = obid(); item < 4096; item += gridDim.x) {
        const int n = item >> 3, head = item & 7, row0 = n * 64;
        int rowbase, L; if (row0 < 16384) { rowbase = row0 & ~4095; L = 4096; } else { rowbase = 16384 + ((row0 - 16384) & ~2047); L = 2048; }
        const int t0 = row0 - rowbase;
#pragma unroll
        for (int i = 0; i < 2; ++i) { const int c = tid + i * 512, r = c >> 4, cc = c & 15;
            *(u32x4*)(T + r * 136 + cc * 8) = *(const u32x4*)(QKV + (size_t)(row0 + r) * 3072 + 2048 + head * 128 + cc * 8); }
        __syncthreads();
        { const int e = tid >> 2, tq = (tid & 3) * 16; unsigned w[8];
#pragma unroll
          for (int i = 0; i < 8; ++i) w[i] = (unsigned)T[(tq + 2 * i) * 136 + e] | ((unsigned)T[(tq + 2 * i + 1) * 136 + e] << 16);
          bf16* dst = VT + (size_t)rowbase * 1024 + (size_t)(head * 128 + e) * L + t0 + tq;
          *(u32x4*)dst = (u32x4){w[0], w[1], w[4], w[5]}; *(u32x4*)(dst + 8) = (u32x4){w[2], w[3], w[6], w[7]}; }
        __syncthreads();
    }
}
DI void diff_unit2(unsigned char* lds, const bf16* Qb, const bf16* Kb, const bf16* VTb, int L, int kt0, int kt1,
                   bf16* Ob, int qpos0, float slope2, float negSB2, float lam, const float* sub_gain, float outscale) {
    constexpr int KS = 136, VS = 72, KBUF = 64 * KS * 2  , VBUF = 128 * VS * 2  , VOFF = 2 * KBUF;
    float* EX = (float*)lds;
    const int tid = otid(), lane = tid & 63, wave = tid >> 6, l31 = lane & 31, hi = lane >> 5, qg = wave & 3, sel = wave >> 2;
    const int kcol = sel * 64;
    bf16x8 qf[4];
    { const bf16* qp = Qb + (size_t)(qg * 32 + l31) * 3072 + kcol + 8 * hi;
#pragma unroll
      for (int s = 0; s < 4; ++s) qf[s] = *(const bf16x8*)(qp + 16 * s); }
    f32x16 O[4];
#pragma unroll
    for (int nb = 0; nb < 4; ++nb) O[nb] = f32x16{};
    float lsum = 0.f;
    const float qposf = (float)(qpos0 + qg * 32 + l31);
    const int kr0 = tid >> 4, kc0 = (tid & 15) * 8, ve0 = tid >> 3, vc0 = (tid & 7) * 8;
    const bf16* kg = Kb + (size_t)kr0 * 3072 + kc0; const bf16* vg = VTb + (size_t)ve0 * L + vc0;
    u32x4 kreg[2], vreg[2];
#define D2_LOAD(t) do { kreg[0] = *(const u32x4*)(kg + (size_t)((t) * 64) * 3072); kreg[1] = *(const u32x4*)(kg + (size_t)((t) * 64 + 32) * 3072); \
                        vreg[0] = *(const u32x4*)(vg + (t) * 64); vreg[1] = *(const u32x4*)(vg + (size_t)64 * L + (t) * 64); } while (0)
#define D2_STORE(b) do { bf16* ks_ = (bf16*)(lds + (b) * KBUF); bf16* vs_ = (bf16*)(lds + VOFF + (b) * VBUF); \
                         *(u32x4*)(ks_ + kr0 * KS + kc0) = kreg[0]; *(u32x4*)(ks_ + (kr0 + 32) * KS + kc0) = kreg[1]; \
                         *(u32x4*)(vs_ + ve0 * VS + vc0) = vreg[0]; *(u32x4*)(vs_ + (ve0 + 64) * VS + vc0) = vreg[1]; } while (0)
    D2_LOAD(kt0); D2_STORE(0);
    __syncthreads();
    for (int t = kt0; t < kt1; ++t) {
        const int b = (t - kt0) & 1;
        if (t + 1 < kt1) D2_LOAD(t + 1);
        const bf16* Ks = (const bf16*)(lds + b * KBUF); const bf16* Vt = (const bf16*)(lds + VOFF + b * VBUF);
        bf16x8 kf[4][2];
#pragma unroll
        for (int s = 0; s < 4; ++s)
#pragma unroll
            for (int kb = 0; kb < 2; ++kb) kf[s][kb] = *(const bf16x8*)(Ks + (32 * kb + l31) * KS + kcol + 16 * s + 8 * hi);
        f32x16 st[2];
#pragma unroll
        for (int r = 0; r < 16; ++r) { st[0][r] = negSB2; st[1][r] = negSB2; }
        __builtin_amdgcn_sched_barrier(0);
#pragma unroll
        for (int s = 0; s < 4; ++s)
#pragma unroll
            for (int kb = 0; kb < 2; ++kb) st[kb] = mfma32(kf[s][kb], qf[s], st[kb]);
        u32x4 vA[4], vB[4];
#define D2_VLD(dst, nb) do { _Pragma("unroll") for (int q_ = 0; q_ < 4; ++q_) dst[q_] = *(const u32x4*)(Vt + (32 * (nb) + l31) * VS + 32 * (q_ >> 1) + 16 * (q_ & 1) + 8 * hi); } while (0)
#define D2_VMM(src, nb) do { _Pragma("unroll") for (int q_ = 0; q_ < 4; ++q_) O[nb] = mfma32(pf[q_ >> 1][q_ & 1], __builtin_bit_cast(bf16x8, src[q_]), O[nb]); } while (0)
        D2_VLD(vA, 0);
        bf16x8 pf[2][2];
#pragma unroll
        for (int kb = 0; kb < 2; ++kb) {
            const float base = qposf - (float)(t * 64 + 32 * kb + 4 * hi);
            float p[16];
#pragma unroll
            for (int r = 0; r < 16; ++r) { const float dl = base - (float)((r & 3) + 8 * (r >> 2)); p[r] = __builtin_amdgcn_exp2f(st[kb][r] - slope2 * fabsf(dl)); lsum += p[r]; }
            pf[kb][0] = __builtin_bit_cast(bf16x8, pack8u(p)); pf[kb][1] = __builtin_bit_cast(bf16x8, pack8u(p + 8));
        }
        __builtin_amdgcn_sched_barrier(0);
        D2_VLD(vB, 1); D2_VMM(vA, 0);
        __builtin_amdgcn_sched_barrier(0);
        D2_VLD(vA, 2); D2_VMM(vB, 1);
        __builtin_amdgcn_sched_barrier(0);
        D2_VLD(vB, 3); D2_VMM(vA, 2);
        __builtin_amdgcn_sched_barrier(0);
        D2_VMM(vB, 3);
#undef D2_VLD
#undef D2_VMM
        if (t + 1 < kt1) D2_STORE(b ^ 1);
        __syncthreads();
    }
#undef D2_LOAD
#undef D2_STORE
    lsum += __shfl_xor(lsum, 32);
    float invl[16];
#pragma unroll
    for (int r = 0; r < 16; ++r) invl[r] = 1.f / __shfl(lsum, crow(r, hi));
#pragma unroll
    for (int nb = 0; nb < 4; ++nb)
#pragma unroll
        for (int r = 0; r < 16; ++r) O[nb][r] *= invl[r];
    if (sel == 1) {
#pragma unroll
        for (int nb = 0; nb < 4; ++nb)
#pragma unroll
            for (int r = 0; r < 16; ++r) EX[((qg * 4 + nb) * 16 + r) * 64 + lane] = O[nb][r]; }
    __syncthreads();
    if (sel == 0) {
        float sq[16];
#pragma unroll
        for (int r = 0; r < 16; ++r) sq[r] = 0.f;
#pragma unroll
        for (int nb = 0; nb < 4; ++nb)
#pragma unroll
            for (int r = 0; r < 16; ++r) { const float v = O[nb][r] - lam * EX[((qg * 4 + nb) * 16 + r) * 64 + lane]; O[nb][r] = v; sq[r] += v * v; }
#pragma unroll
        for (int r = 0; r < 16; ++r) { float v = sq[r]; v += __shfl_xor(v, 1); v += __shfl_xor(v, 2); v += __shfl_xor(v, 4); v += __shfl_xor(v, 8); v += __shfl_xor(v, 16);
            sq[r] = outscale / sqrtf(v * (1.f / 128.f) + 1e-6f); }
#pragma unroll
        for (int nb = 0; nb < 4; ++nb) { const float gn = sub_gain[32 * nb + l31];
#pragma unroll
            for (int r = 0; r < 16; ++r) Ob[(size_t)(qg * 32 + crow(r, hi)) * 3072 + 32 * nb + l31] = f2b(O[nb][r] * sq[r] * gn); }
    }
    __syncthreads();
}
DI void diff_attn_phase2(int o, int layer, unsigned char* lds, bf16* QKV, const bf16* VT) {
    const KArgs& a = *kargs();
    const int lane = otid() & 63;
    const float gq = wave_max(fabsf(a.in[24][o * 64 + lane])), gk = wave_max(fabsf(a.in[25][o * 64 + lane]));
    const float SB2 = (8.f * gq * gk * 1.02f + 0.5f) * LOG2E;
    const float d1 = wave_sum(a.in[26][o * 64 + lane] * a.in[27][o * 64 + lane]), d2 = wave_sum(a.in[28][o * 64 + lane] * a.in[29][o * 64 + lane]);
    const float lambda_init = 0.8f - 0.6f * expf(-0.3f * (float)layer);
    const float lam = expf(d1) - expf(d2) + lambda_init;
    for (int b = obid(); b < 256; b += gridDim.x)
    for (int i = 0; i < 8; ++i) { const int hb = b >> 5;
        int head, qb, L, rowbase;
        if (i < 4) { const int el = (i + (hb >> 1)) & 3; const int tA = (0x4370 >> (4 * el)) & 15, tB = (0x5261 >> (4 * el)) & 15;
            head = (hb & 1) ? tB : tA; qb = b & 31; L = 4096; rowbase = i * 4096; }
        else { const int j = i - 4, sb = (b >> 4) & 15; const int el = (j + (hb >> 1)) & 3; const int tA = (0x4370 >> (4 * el)) & 15, tB = (0x5261 >> (4 * el)) & 15;
            head = (hb & 1) ? tA : tB; qb = b & 15; L = 2048; rowbase = 16384 + (2 * j + (sb & 1)) * 2048; }
        const float slope2 = exp2f(-(float)(head + 1)) * LOG2E;
        const int dmin = (int)((2.f * SB2 + 40.f) / slope2) + 1;
        const int q0 = qb * 128;
        int kt0 = (q0 - dmin) / 64; if (q0 - dmin < 0) kt0 = 0;
        int kt1 = (q0 + 127 + dmin) / 64 + 1; if (kt1 > L / 64) kt1 = L / 64;
        bf16* Qb = QKV + (size_t)(rowbase + q0) * 3072 + head * 128;
        const bf16* Kb = QKV + (size_t)rowbase * 3072 + 1024 + head * 128; const bf16* VTb = VT + (size_t)rowbase * 1024 + (size_t)(head * 128) * L;
        diff_unit2(lds, Qb, Kb, VTb, L, kt0, kt1, Qb, q0, slope2, -SB2, lam, a.in[30] + o * 128, 1.f - lambda_init);
    }
}
DI void vt_prep_x(unsigned char* lds, const bf16* KVX, bf16* VTX) {
    const int tid = otid(); bf16* T = (bf16*)lds;
    for (int item = obid(); item < 192; item += gridDim.x) {
        const int sh = item >> 2, kt = item & 3, seq = sh >> 2, head = sh & 3;
#pragma unroll
        for (int i = 0; i < 4; ++i) { const int c = tid + i * 512, r = c >> 5, cc = c & 31;
            *(u32x4*)(T + r * 264 + cc * 8) = *(const u32x4*)(KVX + (size_t)(seq * 256 + kt * 64 + r) * 2048 + 1024 + head * 256 + cc * 8); }
        __syncthreads();
        { const int e = tid >> 1, tq = (tid & 1) * 32; unsigned w[16];
#pragma unroll
          for (int i = 0; i < 16; ++i) w[i] = (unsigned)T[(tq + 2 * i) * 264 + e] | ((unsigned)T[(tq + 2 * i + 1) * 264 + e] << 16);
          bf16* dst = VTX + (size_t)(sh * 256 + e) * 256 + kt * 64 + tq;
#pragma unroll
          for (int i = 0; i < 2; ++i) { *(u32x4*)(dst + 16 * i) = (u32x4){w[8 * i], w[8 * i + 1], w[8 * i + 4], w[8 * i + 5]}; *(u32x4*)(dst + 16 * i + 8) = (u32x4){w[8 * i + 2], w[8 * i + 3], w[8 * i + 6], w[8 * i + 7]}; } }
        __syncthreads();
    }
}
DI void cross_unit2(unsigned char* lds, const bf16* Qb, const bf16* Kb, const bf16* VTb, bf16* Ob, float negSB2) {
    constexpr int KS = 264, VS = 40, KBUF = 32 * KS * 2  , VBUF = 256 * VS * 2  , VOFF = 2 * KBUF, NT = 8;
    const int tid = otid(), lane = tid & 63, wave = tid >> 6, l31 = lane & 31, hi = lane >> 5, qg = wave & 3, sel = wave >> 2;
    const int vrow0 = sel * 128;
    bf16x8 qf[16];
    { const bf16* qp = Qb + (size_t)(qg * 32 + l31) * 1024 + 8 * hi;
#pragma unroll
      for (int s = 0; s < 16; ++s) qf[s] = *(const bf16x8*)(qp + 16 * s); }
    f32x16 O[4];
#pragma unroll
    for (int nb = 0; nb < 4; ++nb) O[nb] = f32x16{};
    float lsum = 0.f;
    const int kr0 = tid >> 5, kc0 = (tid & 31) * 8, ve0 = tid >> 2, vc0 = (tid & 3) * 8;
    const bf16* kg = Kb + (size_t)kr0 * 2048 + kc0; const bf16* vg = VTb + (size_t)ve0 * 256 + vc0;
    u32x4 kreg[2], vreg[2];
#define X2_LOAD(t) do { kreg[0] = *(const u32x4*)(kg + (size_t)((t) * 32) * 2048); kreg[1] = *(const u32x4*)(kg + (size_t)((t) * 32 + 16) * 2048); \
                        vreg[0] = *(const u32x4*)(vg + (t) * 32); vreg[1] = *(const u32x4*)(vg + 128 * 256 + (t) * 32); } while (0)
#define X2_STORE(b) do { bf16* ks_ = (bf16*)(lds + (b) * KBUF); bf16* vs_ = (bf16*)(lds + VOFF + (b) * VBUF); \
                         *(u32x4*)(ks_ + kr0 * KS + kc0) = kreg[0]; *(u32x4*)(ks_ + (kr0 + 16) * KS + kc0) = kreg[1]; \
                         *(u32x4*)(vs_ + ve0 * VS + vc0) = vreg[0]; *(u32x4*)(vs_ + (ve0 + 128) * VS + vc0) = vreg[1]; } while (0)
    X2_LOAD(0); X2_STORE(0);
    __syncthreads();
#pragma unroll 1
    for (int t = 0; t < NT; ++t) {
        const int b = t & 1;
        if (t + 1 < NT) X2_LOAD(t + 1);
        const bf16* Ks = (const bf16*)(lds + b * KBUF); const bf16* Vt = (const bf16*)(lds + VOFF + b * VBUF);
        f32x16 st;
#pragma unroll
        for (int r = 0; r < 16; ++r) st[r] = negSB2;
#pragma unroll
        for (int s = 0; s < 16; ++s) { const bf16x8 av = *(const bf16x8*)(Ks + l31 * KS + 16 * s + 8 * hi); st = mfma32(av, qf[s], st); }
        float p[16];
#pragma unroll
        for (int r = 0; r < 16; ++r) { p[r] = __builtin_amdgcn_exp2f(st[r]); lsum += p[r]; }
        const bf16x8 pf0 = __builtin_bit_cast(bf16x8, pack8u(p)), pf1 = __builtin_bit_cast(bf16x8, pack8u(p + 8));
#pragma unroll
        for (int nb = 0; nb < 4; ++nb)
#pragma unroll
            for (int s2 = 0; s2 < 2; ++s2) { const u32x4 bw = *(const u32x4*)(Vt + (vrow0 + 32 * nb + l31) * VS + 16 * s2 + 8 * hi); O[nb] = mfma32(s2 ? pf1 : pf0, __builtin_bit_cast(bf16x8, bw), O[nb]); }
        if (t + 1 < NT) X2_STORE(b ^ 1);
        __syncthreads();
    }
#undef X2_LOAD
#undef X2_STORE
    lsum += __shfl_xor(lsum, 32);
    float invl[16];
#pragma unroll
    for (int r = 0; r < 16; ++r) invl[r] = 1.f / __shfl(lsum, crow(r, hi));
#pragma unroll
    for (int nb = 0; nb < 4; ++nb)
#pragma unroll
        for (int r = 0; r < 16; ++r) Ob[(size_t)(qg * 32 + crow(r, hi)) * 1024 + sel * 128 + 32 * nb + l31] = f2b(O[nb][r] * invl[r]);
}
DI void cross_attn_phase2(int layer, unsigned char* lds, bf16* qx, const bf16* kvx, const bf16* vtx) {
    const KArgs& a = *kargs();
    const int lane = otid() & 63;
    float gq = 0.f, gk = 0.f;
#pragma unroll
    for (int i = 0; i < 4; ++i) { gq = fmaxf(gq, fabsf(a.in[34][layer * 256 + lane + 64 * i])); gk = fmaxf(gk, fabsf(a.in[35][layer * 256 + lane + 64 * i])); }
    gq = wave_max(gq); gk = wave_max(gk);
    const float negSB2 = -(16.f * gq * gk * 1.02f + 0.5f) * LOG2E;
    for (int u = obid(); u < 1024; u += gridDim.x) {
        const int rb = u >> 2, head = u & 3, row0 = rb * 128; const int seq = row0 < 16384 ? (row0 >> 12) : 4 + ((row0 - 16384) >> 11);
        bf16* Qb = qx + (size_t)row0 * 1024 + head * 256; const bf16* Kb = kvx + (size_t)(seq * 256) * 2048 + head * 256; const bf16* VTb = vtx + (size_t)((seq * 4 + head) * 256) * 256;
        cross_unit2(lds, Qb, Kb, VTb, Qb, negSB2);
    }
}
#define LAS __attribute__((address_space(3)))
#define XB_TMO      128
#define XB_XCNT(j)  (256  + 64 * (j))
#define XB_XSUB(j)  (1280 + 64 * (j))
#define XB_XGEN(j)  (2304 + 64 * (j))
#define XB_TOP      3328
#define XB_TOPGEN   3392
#define XCD_BAR_WORDS 3456
#define XB_SPIN_CAP (1u << 18)

__device__ __forceinline__ unsigned xb_ld(unsigned* p)              { return __hip_atomic_load(p, __ATOMIC_RELAXED, __HIP_MEMORY_SCOPE_AGENT); }
__device__ __forceinline__ unsigned xb_add(unsigned* p, unsigned v) { return __hip_atomic_fetch_add(p, v, __ATOMIC_RELAXED, __HIP_MEMORY_SCOPE_AGENT); }
__device__ __forceinline__ unsigned xb_xcc_id() { return (unsigned)__builtin_amdgcn_s_getreg((3 << 11) | 20) & 0xFu; }
#define XB_SPIN(cond, bar) do { unsigned _sp = 0; while (cond) { __builtin_amdgcn_s_sleep(1); \
    if ((++_sp & 255u) == 0u) { if (xb_ld(&(bar)[XB_TMO])) break; if (_sp > XB_SPIN_CAP) { atomicAdd(&(bar)[XB_TMO], 1u); break; } } } } while (0)

struct XcdBarrier {
    unsigned* bar; unsigned x;
    volatile LAS unsigned* st;
};

__device__ __forceinline__ XcdBarrier xcd_barrier_post(unsigned* bar, volatile LAS unsigned* st) {
    XcdBarrier b; b.bar = bar; b.x = xb_xcc_id(); b.st = st;
    if (threadIdx.x == 0) (void)xb_add(&bar[XB_XCNT(b.x)], 1u);
    return b;
}
__device__ __forceinline__ void xcd_barrier_complete(unsigned* bar, unsigned x, unsigned& nloc, unsigned& nx) {
    const unsigned G = gridDim.x * gridDim.y * gridDim.z;
    unsigned sum, cnt, mine, sp = 0u;
    for (;;) {
        sum = 0u; cnt = 0u; mine = 0u;
#pragma unroll
        for (unsigned j = 0; j < 16; ++j) { const unsigned c = xb_ld(&bar[XB_XCNT(j)]); sum += c; cnt += (c > 0u) ? 1u : 0u; mine = (j == x) ? c : mine; }
        if (sum == G) break;
        __builtin_amdgcn_s_sleep(1);
        if ((++sp & 255u) == 0u) { if (xb_ld(&bar[XB_TMO])) break; if (sp > XB_SPIN_CAP) { atomicAdd(&bar[XB_TMO], 1u); break; } }
    }
    nloc = mine > 0u ? mine : 1u; nx = cnt > 0u ? cnt : 1u;
}

__device__ __forceinline__ void xcd_barrier(const XcdBarrier& b) {
    asm volatile("s_waitcnt vmcnt(0)" ::: "memory");
    __syncthreads();
    if (threadIdx.x == 0) {
        unsigned* bar = b.bar;
        __builtin_amdgcn_s_waitcnt(0);
        unsigned nloc = b.st[0], nx = b.st[1];
        if (nloc == 0u) { xcd_barrier_complete(bar, b.x, nloc, nx); b.st[0] = nloc; b.st[1] = nx; }
        const unsigned old = xb_add(&bar[XB_XSUB(b.x)], 1u);
        const unsigned gen = old / nloc;
        if (old + 1u == (gen + 1u) * nloc) {
            __builtin_amdgcn_fence(__ATOMIC_RELEASE, "agent");
            asm volatile("s_waitcnt vmcnt(0)" ::: "memory");
            const unsigned og = xb_add(&bar[XB_TOP], 1u);
            const unsigned tg = og / nx;
            if (og + 1u == (tg + 1u) * nx) xb_add(&bar[XB_TOPGEN], 1u);
            else XB_SPIN(xb_ld(&bar[XB_TOPGEN]) == tg, bar);
            __builtin_amdgcn_fence(__ATOMIC_ACQUIRE, "agent");
            xb_add(&bar[XB_XGEN(b.x)], 1u);
            asm volatile("s_waitcnt vmcnt(0)" ::: "memory");
        } else {
            XB_SPIN(xb_ld(&bar[XB_XGEN(b.x)]) == gen, bar);
            __builtin_amdgcn_fence(__ATOMIC_ACQUIRE, "agent");
            asm volatile("s_waitcnt vmcnt(0)" ::: "memory");
        }
    }
    __syncthreads();
}

__global__ void __launch_bounds__(512, 2) fwd_kernel(KArgs a) {
    extern __shared__ __attribute__((aligned(16))) unsigned char lds[];
    cg::grid_group grid = cg::this_grid();
    unsigned char* ws = a.ws; float* OUT = a.out;
    volatile LAS unsigned* MISC = (volatile LAS unsigned*)((LAS unsigned char*)lds + 131072 + 64);
    if (threadIdx.x < 2) MISC[threadIdx.x] = 0u;
    if (blockIdx.x == 0) for (int i = threadIdx.x; i < XCD_BAR_WORDS; i += 512) ((unsigned*)ws)[i] = 0u;
    __syncthreads();
    grid.sync();
    (void)xcd_barrier_post((unsigned*)ws, MISC);
#define GRID_BAR() do { XcdBarrier b_; b_.bar = (unsigned*)ws; b_.x = xb_xcc_id(); b_.st = (volatile LAS unsigned*)((LAS unsigned char*)lds + 131072 + 64); xcd_barrier(b_); } while (0)
    bf16* RB = (bf16*)(ws + WS_HN);
    bf16* HN = (bf16*)a.out; bf16* BIG = (bf16*)(ws + WS_BIG); bf16* MN = (bf16*)(ws + WS_MN);
    bf16* XBB = (bf16*)(ws + WS_XBB); float* RSQ = (float*)(ws + WS_ROWSQ);
    bf16* YF = HN; bf16* YB = HN + (size_t)MTOK * 512; bf16* KVB = (bf16*)(ws + WS_KV); float* DEC = (float*)(ws + WS_DEC); bf16* KVX = (bf16*)(ws + WS_KVX);
#pragma unroll 1
    for (int layer = 0; layer < 4; ++layer) {
        const bool even = !(layer & 1); const int hl = layer >> 1;
#pragma unroll 1
        for (int step = 0; step < 15; ++step) {
            bool sync = true;
            switch (step) {
            case 0:
              for (int rep_ = 0; rep_ < (PROBE == 6 ? 2 : 1); ++rep_) {
                convert_weights(layer, lds);
                if (layer == 0) prep_rows(kargs()->in[0], kargs()->in[1], RB, RSQ);
                norm_rows<false>(kargs()->in[2], kargs()->in[3], 1024, 3072, kargs()->in[6] + layer * 1024, MN, nullptr);
              }
                break;
            case 1: for (int rep_ = 0; rep_ < (PROBE == 1 ? 2 : 1); ++rep_) if (even) run_gemm<MTOK, 2304, 1024, 1024>(lds, RB, (const bf16*)(ws + W_IN), pg8::EpiB<0, true>{BIG, 2304, RSQ}); else run_gemm<MTOK, 3072, 1024, 1024>(lds, RB, (const bf16*)(ws + W_IN), pg8::EpiQKV{BIG, RSQ, kargs()->in[24] + hl * 64, kargs()->in[25] + hl * 64, 0.125f * LOG2E}); break;
            case 2:
                if (even) { for (int rep_ = 0; rep_ < (PROBE == 2 ? 2 : 1); ++rep_) { s5_phase(hl, lds, BIG, YF, YB); __syncthreads(); } for (int rep_ = 0; rep_ < (PROBE == 3 ? 2 : 1); ++rep_) gla_g1(hl, lds, BIG, KVB, DEC); }
                else vt_prep(lds, BIG, HN);
                break;
            case 3:
                if (even) { gla_g2(KVB, DEC); s5_combine(hl, BIG, YF, YB); }
                else diff_attn_phase2(hl, layer, lds, BIG, HN);
                break;
            case 4:
                if (even) { for (int rep_ = 0; rep_ < (PROBE == 3 ? 2 : 1); ++rep_) gla_g3(hl, lds, BIG, KVB, HN); run_gemm<MTOK, 512, 512, 2304>(lds, BIG, (const bf16*)(ws + W_GLU), pg8::EpiGlu{BIG, 2304, HN, 1024}); }
                else sync = false;
                break;
            case 5: if (even) run_gemm<MTOK, 1024, 1024, 1024>(lds, HN, (const bf16*)(ws + W_OUT), pg8::EpiRes3<false>{RB, RSQ + 1 * 524288, nullptr}); else run_gemm<MTOK, 1024, 1024, 3072>(lds, BIG, (const bf16*)(ws + W_OUT), pg8::EpiRes3<false>{RB, RSQ + 1 * 524288, nullptr}); break;
            case 6: sync = false; break;
            case 7: for (int rep_ = 0; rep_ < (PROBE == 1 ? 2 : 1); ++rep_) run_gemm<MTOK, 1024, 1024, 1024>(lds, RB, (const bf16*)(ws + W_XQ), pg8::EpiB<0, true>{BIG, 1024, RSQ + 1 * 524288}); sync = false; break;
            case 8: for (int rep_ = 0; rep_ < (PROBE == 1 ? 2 : 1); ++rep_) run_gemm<3072, 2048, 1024, 1024>(lds, MN, (const bf16*)(ws + W_XKV), pg8::EpiB<0>{KVX, 2048, nullptr}); break;
            case 9:
                segnorm(BIG, 1024, MTOK, 2, 256, kargs()->in[34] + layer * 256, 0.0625f * LOG2E, 2, kargs()->in[34] + layer * 256, 0.0625f * LOG2E);
                segnorm(KVX, 2048, 3072, 2, 256, kargs()->in[35] + layer * 256, 1.f, 2, kargs()->in[35] + layer * 256, 1.f);
                vt_prep_x(lds, KVX, (bf16*)(ws + WS_KVX + 16 * MiB));
                break;
            case 10: cross_attn_phase2(layer, lds, BIG, KVX, (const bf16*)(ws + WS_KVX + 16 * MiB)); break;
            case 11: run_gemm<MTOK, 1024, 1024, 1024>(lds, BIG, (const bf16*)(ws + W_XO), pg8::EpiRes3<false>{RB, RSQ + 2 * 524288, nullptr}); break;
            case 12: sync = false; break;
            case 13: for (int rep_ = 0; rep_ < (PROBE == 1 ? 2 : 1); ++rep_) run_gemm<MTOK, 4096, 1024, 1024>(lds, RB, (const bf16*)(ws + W_1), pg8::EpiB<1, true>{BIG, 4096, RSQ + 2 * 524288}); break;
            default: if (layer == 3) run_gemm<MTOK, 1024, 4096, 4096>(lds, BIG, (const bf16*)(ws + W_2), pg8::EpiRes3<true>{RB, nullptr, OUT});
                     else run_gemm<MTOK, 1024, 4096, 4096>(lds, BIG, (const bf16*)(ws + W_2), pg8::EpiRes3<false>{RB, RSQ, nullptr}); break;
            }
            if (sync) { GRID_BAR(); if (PROBE == 4) GRID_BAR(); }
        }
    }
}
extern "C" void kernel_launch(void* const* d_in, const int* in_sizes, int n_in, void* d_out, int out_size, void* d_ws, size_t ws_size, hipStream_t stream) {
    static int grid = 0;
    if (grid == 0) {
        if (n_in != 38 || out_size != MTOK * 1024 || ws_size < WS_END) { fprintf(stderr, "kernel_launch: unexpected shapes n_in %d out %d ws %zu (need %zu)\n", n_in, out_size, ws_size, (size_t)WS_END); grid = -1; return; }
        int dev = 0, cus = 0, per_cu = 0;
        hipGetDevice(&dev); hipDeviceGetAttribute(&cus, hipDeviceAttributeMultiprocessorCount, dev);
        if (hipFuncSetAttribute((const void*)fwd_kernel, hipFuncAttributeMaxDynamicSharedMemorySize, LDS_BYTES) != hipSuccess) { fprintf(stderr, "kernel_launch: hipFuncSetAttribute failed\n"); grid = -1; return; }
        if (hipOccupancyMaxActiveBlocksPerMultiprocessor(&per_cu, (const void*)fwd_kernel, 512, LDS_BYTES) != hipSuccess || per_cu < 1) { fprintf(stderr, "kernel_launch: occupancy query gave %d\n", per_cu); per_cu = 1; }
        (void)hipGetLastError();
        grid = cus * (per_cu > 1 ? 1 : per_cu);
        if (grid <= 0) grid = 256;
    }
    if (grid < 0) return;
    KArgs a{};
    for (int i = 0; i < 38; ++i) a.in[i] = (const float*)d_in[i];
    a.out = (float*)d_out; a.ws = (unsigned char*)d_ws;
    void* args[] = {&a};
    hipError_t e = hipLaunchCooperativeKernel((const void*)fwd_kernel, dim3(grid), dim3(512), args, LDS_BYTES, stream);
    if (e != hipSuccess) fprintf(stderr, "cooperative launch failed: %s (grid %d)\n", hipGetErrorString(e), grid);
}
```

```cpp
#include <hip/hip_runtime.h>
#include <hip/hip_cooperative_groups.h>
#include <cstdio>
#include <cstdint>
namespace cg = cooperative_groups;
#ifndef PROBE
#define PROBE 0
#endif
__device__ __forceinline__ int otid() { int t = threadIdx.x; asm volatile("" : "+v"(t)); return t; }
__device__ __forceinline__ int obid() { int b = blockIdx.x; asm volatile("" : "+s"(b)); return b; }
namespace pg8 {
#define PG8_LAS __attribute__((address_space(3)))
typedef unsigned short bf16_t;
typedef short bf16x8 __attribute__((ext_vector_type(8)));
typedef float f32x4 __attribute__((ext_vector_type(4)));
typedef unsigned u32x4 __attribute__((ext_vector_type(4)));
constexpr int BM = 256, BK = 64, HALF = 128, HTB = HALF * BK * 2  , STAGE_BYTES = 8 * HTB, NXCD = 8, WGM = 8;

__host__ __device__ __forceinline__ int lds_byte(int r, int c) { const int st = (r >> 4) * 2 + (c >> 5), rr = r & 15, cc = c & 31, ob = rr * 64 + cc * 2; return st * 1024 + (ob ^ (((ob >> 9) & 1) << 5)); }
__host__ __device__ __forceinline__ void stage_rc(int b, int& R, int& C) { const int st = b / 1024, sb = b % 1024, swz = sb ^ (((sb >> 9) & 1) << 5); R = (st >> 1) * 16 + swz / 64; C = (st & 1) * 32 + (swz % 64) / 2; }
__host__ __device__ __forceinline__ int perm32(int rho) { const int n = rho >> 4, i = rho & 15; return 8 * (i >> 2) + 4 * n + (i & 3); }

struct Unit { int pm, pn; };
struct Gemm { const bf16_t* A; int lda; const bf16_t* Bt; int M, N, K; };

struct StaticOrder {
    int nM, nN, nwg, G, c;
    __host__ __device__ void init(int M, int N, int G_, int c_) { nM = M / BM; nN = N / BM; nwg = nM * nN; G = G_; c = c_; }
    __host__ __device__ bool next(int i, Unit& u) const {
        const long L = (long)i * G + c; if (L >= nwg) return false;
        int wgid = (int)L; { const int q = nwg / NXCD, r = nwg % NXCD, xcd = wgid % NXCD, off = wgid / NXCD; wgid = (xcd < r ? xcd * (q + 1) : r * (q + 1) + (xcd - r) * q) + off; }
        const int nig = WGM * nN, gid = wgid / nig, fm = gid * WGM, gsz = (nM - fm) < WGM ? (nM - fm) : WGM;
        u.pm = fm + ((wgid % nig) % gsz); u.pn = (wgid % nig) / gsz; return true;
    }
    __device__ __forceinline__ void a_ready(const Unit&) const {}
    __device__ __forceinline__ void done(const Unit&) const {}
};

__device__ __forceinline__ unsigned cvt_pk_bf16(float lo, float hi) { unsigned r; asm volatile("v_cvt_pk_bf16_f32 %0, %1, %2" : "=v"(r) : "v"(lo), "v"(hi)); return r; }
typedef float f32x2 __attribute__((ext_vector_type(2)));
typedef float f32x2e __attribute__((ext_vector_type(2)));
typedef __bf16 bf16x2e __attribute__((ext_vector_type(2)));
__device__ __forceinline__ unsigned pk2e(float lo, float hi) { f32x2e v = {lo, hi}; bf16x2e b = __builtin_convertvector(v, bf16x2e); return __builtin_bit_cast(unsigned, b); }
template <int ACT  , bool RS = false  > struct EpiB {
    static constexpr bool PERM = true, AFTER_DRAIN = false;
    bf16_t* O; int ldc; const float* rsq;
    __device__ __forceinline__ void operator()(const f32x4 (&acc)[2][2][4][2], const Unit& u, int wr, int wc, int fr, int fq) const {
        const int row0 = u.pm * BM + wr * 64 + fr, col0 = u.pn * BM + wc * 32 + 8 * fq;
#pragma unroll
        for (int ai = 0; ai < 2; ++ai)
#pragma unroll
            for (int m = 0; m < 4; ++m) { bf16_t* rowp = O + (size_t)(row0 + ai * HALF + m * 16) * ldc + col0;
                float rstd = 1.f; if (RS) { const f32x4 r0 = *((const f32x4*)(rsq + (size_t)(row0 + ai * HALF + m * 16) * 16) + fq); float tot = (r0[0] + r0[1]) + (r0[2] + r0[3]); tot += __shfl_xor(tot, 16); tot += __shfl_xor(tot, 32); rstd = 1.f / sqrtf(tot * (1.f / 1024.f) + 1e-6f); }
#pragma unroll
                for (int bj = 0; bj < 2; ++bj) { f32x4 v0 = acc[ai][bj][m][0], v1 = acc[ai][bj][m][1];
                    if (RS) { v0 = v0 * rstd; v1 = v1 * rstd; }
                    if (ACT == 1) {
#pragma unroll
                        for (int q = 0; q < 4; ++q) { float a = v0[q] > 0.f ? v0[q] : 0.f; v0[q] = a * a; float b = v1[q] > 0.f ? v1[q] : 0.f; v1[q] = b * b; } }
                    u32x4 w; w.x = pk2e(v0[0], v0[1]); w.y = pk2e(v0[2], v0[3]); w.z = pk2e(v1[0], v1[1]); w.w = pk2e(v1[2], v1[3]);
                    *(u32x4*)(rowp + bj * HALF) = w; } }
    }
};
struct EpiRes {
    static constexpr bool PERM = false, AFTER_DRAIN = false;
    float* X; int ldc;
    __device__ __forceinline__ void operator()(const f32x4 (&acc)[2][2][4][2], const Unit& u, int wr, int wc, int fr, int fq) const {
        const int row0 = u.pm * BM + wr * 64 + fr, col0 = u.pn * BM + wc * 32 + 4 * fq;
#pragma unroll
        for (int ai = 0; ai < 2; ++ai)
#pragma unroll
            for (int m = 0; m < 4; ++m) { float* rowp = X + (size_t)(row0 + ai * HALF + m * 16) * ldc + col0;
#pragma unroll
                for (int bj = 0; bj < 2; ++bj)
#pragma unroll
                    for (int n = 0; n < 2; ++n) { f32x4* p = (f32x4*)(rowp + bj * HALF + n * 16); const f32x4 b = *p; *p = b + acc[ai][bj][m][n]; } }
    }
};
template <bool LAST> struct EpiRes3 {
    static constexpr bool PERM = true, AFTER_DRAIN = false;
    bf16_t* R; float* rsq; float* out;
    __device__ __forceinline__ void operator()(const f32x4 (&acc)[2][2][4][2], const Unit& u, int wr, int wc, int fr, int fq) const {
        const int row0 = u.pm * BM + wr * 64 + fr, col0 = u.pn * BM + wc * 32 + 8 * fq;
#pragma unroll
        for (int ai = 0; ai < 2; ++ai)
#pragma unroll
            for (int m = 0; m < 4; ++m) { const size_t row = (size_t)(row0 + ai * HALF + m * 16); bf16_t* bp = R + row * 1024 + col0; float ss = 0.f;
#pragma unroll
                for (int bj = 0; bj < 2; ++bj) { const u32x4 rv = *(const u32x4*)(bp + bj * HALF);
                    f32x4 v0, v1; v0[0] = __uint_as_float(rv.x << 16); v0[1] = __uint_as_float(rv.x & 0xffff0000u); v0[2] = __uint_as_float(rv.y << 16); v0[3] = __uint_as_float(rv.y & 0xffff0000u);
                    v1[0] = __uint_as_float(rv.z << 16); v1[1] = __uint_as_float(rv.z & 0xffff0000u); v1[2] = __uint_as_float(rv.w << 16); v1[3] = __uint_as_float(rv.w & 0xffff0000u);
                    v0 = v0 + acc[ai][bj][m][0]; v1 = v1 + acc[ai][bj][m][1];
                    if (LAST) { f32x4* p = (f32x4*)(out + row * 1024 + col0 + bj * HALF); p[0] = v0; p[1] = v1; }
                    else { u32x4 w; w.x = pk2e(v0[0], v0[1]); w.y = pk2e(v0[2], v0[3]); w.z = pk2e(v1[0], v1[1]); w.w = pk2e(v1[2], v1[3]); *(u32x4*)(bp + bj * HALF) = w;
                        const float a0 = __uint_as_float(w.x << 16), a1 = __uint_as_float(w.x & 0xffff0000u), a2 = __uint_as_float(w.y << 16), a3 = __uint_as_float(w.y & 0xffff0000u);
                        const float a4 = __uint_as_float(w.z << 16), a5 = __uint_as_float(w.z & 0xffff0000u), a6 = __uint_as_float(w.w << 16), a7 = __uint_as_float(w.w & 0xffff0000u);
                        ss += ((a0 * a0 + a1 * a1) + (a2 * a2 + a3 * a3)) + ((a4 * a4 + a5 * a5) + (a6 * a6 + a7 * a7)); } }
                if (!LAST) { ss += __shfl_xor(ss, 16); ss += __shfl_xor(ss, 32); if (fq == 0) rsq[row * 16 + u.pn * 4 + wc] = ss; } }
    }
};
struct EpiQKV {
    static constexpr bool PERM = true, AFTER_DRAIN = false;
    bf16_t* O; const float* rsq; const float* gq; const float* gk; float qscale;
    __device__ __forceinline__ void operator()(const f32x4 (&acc)[2][2][4][2], const Unit& u, int wr, int wc, int fr, int fq) const {
        const int row0 = u.pm * BM + wr * 64 + fr; const bool isqk = u.pn < 8;
        const float* g = u.pn < 4 ? gq : gk; const float sc = u.pn < 4 ? qscale : 1.f;
        f32x4 gv[2][2];
#pragma unroll
        for (int bj = 0; bj < 2; ++bj) { gv[bj][0] = *(const f32x4*)(g + 32 * bj + 8 * fq); gv[bj][1] = *(const f32x4*)(g + 32 * bj + 8 * fq + 4); }
#pragma unroll
        for (int ai = 0; ai < 2; ++ai)
#pragma unroll
            for (int m = 0; m < 4; ++m) { const size_t row = (size_t)(row0 + ai * HALF + m * 16);
                const f32x4 r0 = *((const f32x4*)(rsq + row * 16) + fq); float tot = (r0[0] + r0[1]) + (r0[2] + r0[3]); tot += __shfl_xor(tot, 16); tot += __shfl_xor(tot, 32);
                const float rstd = 1.f / sqrtf(tot * (1.f / 1024.f) + 1e-6f);
                f32x4 v[2][2]; float ss = 0.f;
#pragma unroll
                for (int bj = 0; bj < 2; ++bj)
#pragma unroll
                    for (int n = 0; n < 2; ++n) { v[bj][n] = acc[ai][bj][m][n] * rstd; ss += (v[bj][n][0] * v[bj][n][0] + v[bj][n][1] * v[bj][n][1]) + (v[bj][n][2] * v[bj][n][2] + v[bj][n][3] * v[bj][n][3]); }
                ss += __shfl_xor(ss, 16); ss += __shfl_xor(ss, 32);
                const float rg = isqk ? sc / sqrtf(ss * (1.f / 64.f) + 1e-6f) : 1.f;
#pragma unroll
                for (int bj = 0; bj < 2; ++bj) { f32x4 v0 = v[bj][0], v1 = v[bj][1];
                    if (isqk) { v0 = v0 * gv[bj][0] * rg; v1 = v1 * gv[bj][1] * rg; }
                    u32x4 w; w.x = pk2e(v0[0], v0[1]); w.y = pk2e(v0[2], v0[3]); w.z = pk2e(v1[0], v1[1]); w.w = pk2e(v1[2], v1[3]);
                    const int col = isqk ? (u.pn * BM + 64 * wc + 32 * bj + 8 * fq) : (u.pn * BM + bj * HALF + wc * 32 + 8 * fq);
                    *(u32x4*)(O + row * 3072 + col) = w; } }
    }
};
struct EpiGlu {
    static constexpr bool PERM = true, AFTER_DRAIN = false;
    const bf16_t* Y; int ldy; bf16_t* O; int ldc;
    __device__ __forceinline__ void operator()(const f32x4 (&acc)[2][2][4][2], const Unit& u, int wr, int wc, int fr, int fq) const {
        const int row0 = u.pm * BM + wr * 64 + fr, col0 = u.pn * BM + wc * 32 + 8 * fq;
#pragma unroll
        for (int ai = 0; ai < 2; ++ai)
#pragma unroll
            for (int m = 0; m < 4; ++m) { const size_t row = (size_t)(row0 + ai * HALF + m * 16);
#pragma unroll
                for (int bj = 0; bj < 2; ++bj) { const f32x4 v0 = acc[ai][bj][m][0], v1 = acc[ai][bj][m][1];
                    const u32x4 yv = *(const u32x4*)(Y + row * ldy + col0 + bj * HALF);
                    float y[8]; y[0] = __uint_as_float(yv.x << 16); y[1] = __uint_as_float(yv.x & 0xffff0000u); y[2] = __uint_as_float(yv.y << 16); y[3] = __uint_as_float(yv.y & 0xffff0000u);
                    y[4] = __uint_as_float(yv.z << 16); y[5] = __uint_as_float(yv.z & 0xffff0000u); y[6] = __uint_as_float(yv.w << 16); y[7] = __uint_as_float(yv.w & 0xffff0000u);
                    float o[8];
#pragma unroll
                    for (int q = 0; q < 4; ++q) { o[q] = y[q] / (1.f + __expf(-v0[q])); o[4 + q] = y[4 + q] / (1.f + __expf(-v1[q])); }
                    u32x4 w; w.x = pk2e(o[0], o[1]); w.y = pk2e(o[2], o[3]); w.z = pk2e(o[4], o[5]); w.w = pk2e(o[6], o[7]);
                    *(u32x4*)(O + row * ldc + col0 + bj * HALF) = w; } }
    }
};
template <class Epi, class Sched, bool ALIGN_EPI = false, bool SP2 = false>
__device__ __forceinline__ void gemm_phase(PG8_LAS unsigned char* lds, const Gemm g, const Sched& S, const Epi& E) {
    const int tid = otid(), wid = __builtin_amdgcn_readfirstlane(tid >> 6), lane = tid & 63, wr = wid >> 2, wc = wid & 3, fr = lane & 15, fq = lane >> 4;
    const int K = g.K, nt = K / BK;
    unsigned voffA[2], voffB[2];
#pragma unroll
    for (int i = 0; i < 2; ++i) { int R, C; stage_rc(tid * 16 + i * 8192, R, C); const int Rb = Epi::PERM ? ((R & ~31) + perm32(R & 31)) : R;
        voffA[i] = (unsigned)(R * g.lda + C) * 2u; voffB[i] = (unsigned)(Rb * K + C) * 2u; }
    const size_t kstep = (size_t)(BK * 2);
    const size_t hstep = (size_t)HALF * K * 2;
    const size_t tstep = 2 * hstep;
    const size_t hstepA = (size_t)HALF * g.lda * 2, tstepA = 2 * hstepA;
    const unsigned ldsw = (unsigned)wid * 1024u;
    const int aoff = lds_byte(wr * 64 + fr, fq * 8), boff = lds_byte(wc * 32 + fr, fq * 8);
#define PG8_SA(b, h) (((b) * 2 + (h)) * HTB)
#define PG8_SB(b, h) ((4 + (b) * 2 + (h)) * HTB)
#define PG8_STAGE(bufoff, gbase, voff) do { _Pragma("unroll") for (int _i = 0; _i < 2; ++_i) \
        __builtin_amdgcn_global_load_lds((const unsigned*)((const char*)(gbase) + (voff)[_i]), (PG8_LAS unsigned*)(lds + (bufoff) + ldsw + _i * 8192), 16, 0, 0); } while (0)
#define PG8_LDA(dst, b, h) do { _Pragma("unroll") for (int m = 0; m < 4; ++m) _Pragma("unroll") for (int k = 0; k < 2; ++k) dst[m][k] = *(const PG8_LAS bf16x8*)(lds + PG8_SA(b, h) + aoff + m * 2048 + k * 1024); } while (0)
#define PG8_LDB(dst, b, h) do { _Pragma("unroll") for (int n = 0; n < 2; ++n) _Pragma("unroll") for (int k = 0; k < 2; ++k) dst[n][k] = *(const PG8_LAS bf16x8*)(lds + PG8_SB(b, h) + boff + n * 2048 + k * 1024); } while (0)
#define PG8_MMA(ai, bj, At, Bt) do { __builtin_amdgcn_s_setprio(1); _Pragma("unroll") for (int m = 0; m < 4; ++m) _Pragma("unroll") for (int n = 0; n < 2; ++n) _Pragma("unroll") for (int k = 0; k < 2; ++k) \
        acc[ai][bj][m][n] = __builtin_amdgcn_mfma_f32_16x16x32_bf16(Bt[n][k], At[m][k], acc[ai][bj][m][n], 0, 0, 0); __builtin_amdgcn_s_setprio(0); } while (0)
#define PG8_WAIT_V(n) asm volatile("s_waitcnt vmcnt(" #n ")" ::: "memory")
#define PG8_WAIT_L(n) asm volatile("s_waitcnt lgkmcnt(" #n ")" ::: "memory")
#define PG8_BAR __builtin_amdgcn_s_barrier()
#define PG8_SCHED __builtin_amdgcn_sched_barrier(0)
    Unit cur, nxt; int ui = 0;
    if (!S.next(0, cur)) return;
    f32x4 acc[2][2][4][2];
#pragma unroll
    for (int a = 0; a < 2; ++a)
#pragma unroll
        for (int b = 0; b < 2; ++b)
#pragma unroll
            for (int m = 0; m < 4; ++m)
#pragma unroll
                for (int n = 0; n < 2; ++n) acc[a][b][m][n] = (f32x4){0.f, 0.f, 0.f, 0.f};
    bf16x8 At[4][2], B0[2][2], B1[2][2];
    const char* cA = (const char*)g.A + (size_t)cur.pm * tstepA; const char* cB = (const char*)g.Bt + (size_t)cur.pn * tstep;
    S.a_ready(cur);
    if constexpr (SP2) {
        PG8_STAGE(PG8_SB(0, 0), cB, voffB); PG8_STAGE(PG8_SB(0, 1), cB + hstep, voffB); PG8_STAGE(PG8_SA(0, 0), cA, voffA); PG8_STAGE(PG8_SA(0, 1), cA + hstepA, voffA);
        if (wr == 1) PG8_BAR;
        PG8_WAIT_V(2); PG8_BAR;
        PG8_STAGE(PG8_SB(1, 0), cB + kstep, voffB); PG8_STAGE(PG8_SA(1, 0), cA + kstep, voffA); PG8_STAGE(PG8_SB(1, 1), cB + hstep + kstep, voffB);
        PG8_WAIT_V(6); PG8_BAR;
    } else {
        PG8_STAGE(PG8_SB(0, 0), cB, voffB); PG8_STAGE(PG8_SA(0, 0), cA, voffA); PG8_STAGE(PG8_SB(0, 1), cB + hstep, voffB); PG8_STAGE(PG8_SA(0, 1), cA + hstepA, voffA);
        if (wr == 1) PG8_BAR;
        PG8_WAIT_V(4); PG8_BAR;
        PG8_STAGE(PG8_SB(1, 0), cB + kstep, voffB); PG8_STAGE(PG8_SA(1, 0), cA + kstep, voffA); PG8_STAGE(PG8_SB(1, 1), cB + hstep + kstep, voffB);
        PG8_WAIT_V(6); PG8_BAR;
    }
    for (;;) {
        const bool has_next = S.next(ui + 1, nxt);
        const char* nA = has_next ? (const char*)g.A + (size_t)nxt.pm * tstepA : cA; const char* nB = has_next ? (const char*)g.Bt + (size_t)nxt.pn * tstep : cB;
        for (int t = 0; t < nt; t += 2) {
            const bool last = (t == nt - 2);
            const char* a1 = cA + (size_t)(t + 1) * kstep;
            const char* a2 = last ? nA : cA + (size_t)(t + 2) * kstep; const char* b2 = last ? nB : cB + (size_t)(t + 2) * kstep;
            const char* a3 = a2 + kstep; const char* b3 = b2 + kstep;
            if (last && has_next) S.a_ready(nxt);
            if constexpr (SP2) {
            PG8_LDB(B0, 0, 0); PG8_LDB(B1, 0, 1); PG8_SCHED; PG8_LDA(At, 0, 0); PG8_STAGE(PG8_SA(1, 1), a1 + hstepA, voffA);
            PG8_WAIT_V(8); PG8_WAIT_L(0); PG8_BAR; PG8_MMA(0, 0, At, B0); PG8_MMA(0, 1, At, B1); PG8_BAR; PG8_SCHED;
            PG8_LDA(At, 0, 1); PG8_STAGE(PG8_SB(0, 0), b2, voffB); PG8_STAGE(PG8_SB(0, 1), b2 + hstep, voffB); PG8_STAGE(PG8_SA(0, 0), a2, voffA);
            PG8_WAIT_V(8); PG8_WAIT_L(0); PG8_BAR; PG8_MMA(1, 0, At, B0); PG8_MMA(1, 1, At, B1); PG8_BAR; PG8_SCHED;
            PG8_LDB(B0, 1, 0); PG8_LDB(B1, 1, 1); PG8_SCHED; PG8_LDA(At, 1, 0); PG8_STAGE(PG8_SA(0, 1), a2 + hstepA, voffA);
            PG8_WAIT_V(8); PG8_WAIT_L(0); PG8_BAR; PG8_MMA(0, 0, At, B0); PG8_MMA(0, 1, At, B1); PG8_BAR; PG8_SCHED;
            PG8_LDA(At, 1, 1); PG8_STAGE(PG8_SB(1, 0), b3, voffB); PG8_STAGE(PG8_SB(1, 1), b3 + hstep, voffB); PG8_STAGE(PG8_SA(1, 0), a3, voffA);
            PG8_WAIT_V(8); PG8_WAIT_L(0); PG8_BAR; PG8_MMA(1, 0, At, B0); PG8_MMA(1, 1, At, B1); PG8_BAR; PG8_SCHED;
            } else {
            PG8_LDB(B0, 0, 0); PG8_SCHED; PG8_LDA(At, 0, 0); PG8_STAGE(PG8_SA(1, 1), a1 + hstepA, voffA);
            PG8_WAIT_L(8); PG8_BAR; PG8_WAIT_L(0); PG8_MMA(0, 0, At, B0); PG8_BAR; PG8_SCHED;
            PG8_LDB(B1, 0, 1); PG8_STAGE(PG8_SB(0, 0), b2, voffB);
            PG8_BAR; PG8_WAIT_L(0); PG8_MMA(0, 1, At, B1); PG8_BAR;
            PG8_LDA(At, 0, 1); PG8_STAGE(PG8_SA(0, 0), a2, voffA);
            PG8_BAR; PG8_WAIT_L(0); PG8_MMA(1, 0, At, B0); PG8_BAR; PG8_SCHED;
            PG8_STAGE(PG8_SB(0, 1), b2 + hstep, voffB);
            PG8_WAIT_V(6); PG8_BAR; PG8_MMA(1, 1, At, B1); PG8_BAR;
            PG8_LDB(B0, 1, 0); PG8_SCHED; PG8_LDA(At, 1, 0); PG8_STAGE(PG8_SA(0, 1), a2 + hstepA, voffA);
            PG8_WAIT_L(8); PG8_BAR; PG8_WAIT_L(0); PG8_MMA(0, 0, At, B0); PG8_BAR; PG8_SCHED;
            PG8_LDB(B1, 1, 1); PG8_STAGE(PG8_SB(1, 0), b3, voffB);
            PG8_BAR; PG8_WAIT_L(0); PG8_MMA(0, 1, At, B1); PG8_BAR;
            PG8_LDA(At, 1, 1); PG8_STAGE(PG8_SA(1, 0), a3, voffA);
            PG8_BAR; PG8_WAIT_L(0); PG8_MMA(1, 0, At, B0); PG8_BAR; PG8_SCHED;
            PG8_STAGE(PG8_SB(1, 1), b3 + hstep, voffB);
            PG8_WAIT_V(6); PG8_BAR; PG8_MMA(1, 1, At, B1); PG8_BAR;
            }
        }
        if constexpr (ALIGN_EPI) { if (wr == 0) PG8_BAR; }
        if constexpr (!Epi::AFTER_DRAIN) { E(acc, cur, wr, wc, fr, fq); S.done(cur); }
        if (!has_next) break;
#pragma unroll
        for (int a = 0; a < 2; ++a)
#pragma unroll
            for (int b = 0; b < 2; ++b)
#pragma unroll
                for (int m = 0; m < 4; ++m)
#pragma unroll
                    for (int n = 0; n < 2; ++n) acc[a][b][m][n] = (f32x4){0.f, 0.f, 0.f, 0.f};
        cur = nxt; cA = nA; cB = nB; ++ui;
        if constexpr (ALIGN_EPI) { if (wr == 1) PG8_BAR; }
    }
    PG8_WAIT_V(0);
    if constexpr (!ALIGN_EPI) { if (wr == 0) PG8_BAR; }
    PG8_BAR;
    if constexpr (Epi::AFTER_DRAIN) { E.fused(acc, cur, wr, wc, fr, fq, lds, wid, lane); S.done(cur); }
#undef PG8_SA
#undef PG8_SB
#undef PG8_STAGE
#undef PG8_LDA
#undef PG8_LDB
#undef PG8_MMA
#undef PG8_WAIT_V
#undef PG8_WAIT_L
#undef PG8_BAR
#undef PG8_SCHED
}
}
typedef unsigned short bf16;
typedef short bf16x8 __attribute__((ext_vector_type(8)));
typedef float f32x4 __attribute__((ext_vector_type(4)));
typedef float f32x16 __attribute__((ext_vector_type(16)));
typedef unsigned u32x4 __attribute__((ext_vector_type(4)));
typedef unsigned u32x2 __attribute__((ext_vector_type(2)));
#define DI __device__ __forceinline__
#define LDS_WAIT() asm volatile("s_waitcnt lgkmcnt(0)" ::: "memory")

constexpr int MTOK = 32768;
constexpr size_t MiB = 1u << 20;
constexpr size_t WS_W = 2 * MiB, WS_ROWSQ = 42 * MiB;
constexpr size_t W_IN = WS_W, W_OUT = WS_W + 6 * MiB, W_GLU = WS_W + 8 * MiB, W_XQ = WS_W + 9 * MiB, W_XKV = WS_W + 11 * MiB, W_XO = WS_W + 15 * MiB, W_1 = WS_W + 17 * MiB, W_2 = WS_W + 25 * MiB;
constexpr size_t WS_MN = 35 * MiB, WS_DEC = 41 * MiB, WS_HN = 48 * MiB, WS_BIG = 112 * MiB;
constexpr size_t WS_XBB = WS_BIG + 192 * MiB;
constexpr size_t WS_KV = WS_BIG + 144 * MiB;
constexpr size_t WS_KVX = WS_BIG + 64 * MiB;
constexpr size_t WS_END = WS_BIG + 256 * MiB;
constexpr int LDS_BYTES = 135168;
constexpr float LOG2E = 1.4426950408889634f;

struct KArgs { const float* in[38]; float* out; unsigned char* ws; };
__device__ __forceinline__ const KArgs* kargs() { auto p = __builtin_amdgcn_kernarg_segment_ptr(); asm volatile("" : "+s"(p)); return (const KArgs*)p; }


DI float wave_sum(float v) {
#pragma unroll
    for (int o = 1; o < 64; o <<= 1) v += __shfl_xor(v, o);
    return v;
}
DI float wave_max(float v) {
#pragma unroll
    for (int o = 1; o < 64; o <<= 1) v = fmaxf(v, __shfl_xor(v, o));
    return v;
}
DI unsigned pk2(float lo, float hi) { return pg8::pk2e(lo, hi); }
DI float bflo(unsigned w) { return __uint_as_float(w << 16); }
DI float bfhi(unsigned w) { return __uint_as_float(w & 0xffff0000u); }
DI bf16 f2b(float f) { return (bf16)(pk2(f, 0.f) & 0xffffu); }
DI void unpack8(const u32x4 v, float* f) { f[0] = bflo(v.x); f[1] = bfhi(v.x); f[2] = bflo(v.y); f[3] = bfhi(v.y); f[4] = bflo(v.z); f[5] = bfhi(v.z); f[6] = bflo(v.w); f[7] = bfhi(v.w); }
DI u32x4 pack8u(const float* f) { u32x4 o; o.x = pk2(f[0], f[1]); o.y = pk2(f[2], f[3]); o.z = pk2(f[4], f[5]); o.w = pk2(f[6], f[7]); return o; }
DI f32x16 mfma32(bf16x8 a, bf16x8 b, f32x16 c) { return __builtin_amdgcn_mfma_f32_32x32x16_bf16(a, b, c, 0, 0, 0); }
DI f32x4 mfma16(bf16x8 a, bf16x8 b, f32x4 c) { return __builtin_amdgcn_mfma_f32_16x16x32_bf16(a, b, c, 0, 0, 0); }
DI int crow(int r, int hi) { return (r & 3) + 8 * (r >> 2) + 4 * hi; }

DI void transpose_item(const float* W, int K, int N, bf16* WT, float* scr, int item, int lane, const float* gain = nullptr, int qkperm = 0) {
    const int nblk = N / 32, kb = item / nblk, nb = item % nblk, k0 = 64 * kb, n0 = 32 * nb;
#pragma unroll 8
    for (int i = 0; i < 32; ++i) { const int kk = 2 * i + (lane >> 5); scr[kk * 33 + (lane & 31)] = W[(size_t)(k0 + kk) * N + n0 + (lane & 31)]; }
    LDS_WAIT();
    const int c = lane & 7;
    f32x4 g0 = (f32x4){1.f, 1.f, 1.f, 1.f}, g1 = g0;
    if (gain) { g0 = *(const f32x4*)(gain + k0 + 8 * c); g1 = *(const f32x4*)(gain + k0 + 8 * c + 4); }
#pragma unroll
    for (int j = 0; j < 4; ++j) { const int n = (lane >> 3) + 8 * j; const float* s = scr + (8 * c) * 33 + n;
        u32x4 o; o.x = pk2(s[0 * 33] * g0[0], s[1 * 33] * g0[1]); o.y = pk2(s[2 * 33] * g0[2], s[3 * 33] * g0[3]); o.z = pk2(s[4 * 33] * g1[0], s[5 * 33] * g1[1]); o.w = pk2(s[6 * 33] * g1[2], s[7 * 33] * g1[3]);
        const int cc = n0 + n; const int prow = (qkperm && cc < 2048) ? ((cc & ~255) + 128 * ((cc >> 5) & 1) + 32 * ((cc >> 6) & 3) + (cc & 31)) : cc;
        *(u32x4*)(WT + (size_t)prow * K + k0 + 8 * c) = o; }
    LDS_WAIT();
}
DI void convert_weights(int layer, unsigned char* lds) {
    const KArgs& a = *kargs();
    const int tid = otid(), lane = tid & 63, wave = tid >> 6;
    const int gw = obid() * 8 + wave, NGW = gridDim.x * 8;
    float* scr = (float*)(lds + wave * 8448);
    unsigned char* ws = a.ws;
    const bool even = !(layer & 1); const int hi = layer >> 1;
    const int nIn = even ? 16 * 65 : 16 * 96, nOut = 512, nGlu = even ? 128 : 0, nXq = 512, nXkv = 1024, nXo = 512, n1 = 2048, n2 = 2048;
    const int total = nIn + nOut + nGlu + nXq + nXkv + nXo + n1 + n2;
    for (int it = gw; it < total; it += NGW) {
        int r = it;
        if (r < nIn) { if (even) transpose_item(a.in[8] + (size_t)hi * 1024 * 2080, 1024, 2080, (bf16*)(ws + W_IN), scr, r, lane, a.in[4] + layer * 1024);
                       else transpose_item(a.in[22] + (size_t)hi * 1024 * 3072, 1024, 3072, (bf16*)(ws + W_IN), scr, r, lane, a.in[4] + layer * 1024, 1); continue; } r -= nIn;
        if (r < nOut) { transpose_item((even ? a.in[9] : a.in[23]) + (size_t)hi * 1024 * 1024, 1024, 1024, (bf16*)(ws + W_OUT), scr, r, lane); continue; } r -= nOut;
        if (r < nGlu) { transpose_item(a.in[18] + (size_t)hi * 512 * 512, 512, 512, (bf16*)(ws + W_GLU), scr, r, lane); continue; } r -= nGlu;
        if (r < nXq) { transpose_item(a.in[31] + (size_t)layer * 1024 * 1024, 1024, 1024, (bf16*)(ws + W_XQ), scr, r, lane, a.in[5] + layer * 1024); continue; } r -= nXq;
        if (r < nXkv) { transpose_item(a.in[32] + (size_t)layer * 1024 * 2048, 1024, 2048, (bf16*)(ws + W_XKV), scr, r, lane); continue; } r -= nXkv;
        if (r < nXo) { transpose_item(a.in[33] + (size_t)layer * 1024 * 1024, 1024, 1024, (bf16*)(ws + W_XO), scr, r, lane); continue; } r -= nXo;
        if (r < n1) { transpose_item(a.in[36] + (size_t)layer * 1024 * 4096, 1024, 4096, (bf16*)(ws + W_1), scr, r, lane, a.in[7] + layer * 1024); continue; } r -= n1;
        transpose_item(a.in[37] + (size_t)layer * 4096 * 1024, 4096, 1024, (bf16*)(ws + W_2), scr, r, lane);
    }
    if (even) {
        u32x4* z = (u32x4*)(ws + W_IN + (size_t)2080 * 1024 * 2); const int n16 = 224 * 1024 * 2 / 16;
        for (int i = obid() * 512 + tid; i < n16; i += gridDim.x * 512) z[i] = (u32x4){0u, 0u, 0u, 0u};
    }
}
template <bool COPY> DI void norm_rows(const float* src0, const float* src1, int split, int nrows, const float* gain, bf16* out, float* copy_dst) {
    const int tid = otid(), lane = tid & 63, wave = tid >> 6;
    const int gw = obid() * 8 + wave, NGW = gridDim.x * 8;
    f32x4 g[4];
#pragma unroll
    for (int j = 0; j < 4; ++j) g[j] = ((const f32x4*)gain)[lane + 64 * j];
    for (int m = gw; m < nrows; m += NGW) {
        const float* xr = (m < split) ? src0 + (size_t)m * 1024 : src1 + (size_t)(m - split) * 1024;
        f32x4 v[4]; float s = 0.f;
#pragma unroll
        for (int j = 0; j < 4; ++j) { v[j] = ((const f32x4*)xr)[lane + 64 * j]; s += (v[j].x * v[j].x + v[j].y * v[j].y) + (v[j].z * v[j].z + v[j].w * v[j].w); }
        const float rstd = 1.f / sqrtf(wave_sum(s) * (1.f / 1024.f) + 1e-6f);
        u32x2* o8 = (u32x2*)(out + (size_t)m * 1024);
#pragma unroll
        for (int j = 0; j < 4; ++j) { u32x2 w; w.x = pk2(v[j].x * rstd * g[j].x, v[j].y * rstd * g[j].y); w.y = pk2(v[j].z * rstd * g[j].z, v[j].w * rstd * g[j].w); o8[lane + 64 * j] = w;
            if (COPY) ((f32x4*)(copy_dst + (size_t)m * 1024))[lane + 64 * j] = v[j]; }
    }
}
DI void prep_rows(const float* src0, const float* src1, bf16* R, float* rsq) {
    const int tid = otid(), lane = tid & 63, wave = tid >> 6;
    const int gw = obid() * 8 + wave, NGW = gridDim.x * 8;
    for (int m = gw; m < MTOK; m += NGW) {
        const float* xr = (m < 16384) ? src0 + (size_t)m * 1024 : src1 + (size_t)(m - 16384) * 1024;
        float s = 0.f; u32x2* o8 = (u32x2*)(R + (size_t)m * 1024);
#pragma unroll
        for (int j = 0; j < 4; ++j) { const f32x4 v = ((const f32x4*)xr)[lane + 64 * j]; u32x2 w; w.x = pk2(v.x, v.y); w.y = pk2(v.z, v.w); o8[lane + 64 * j] = w;
            const float a0 = bflo(w.x), a1 = bfhi(w.x), a2 = bflo(w.y), a3 = bfhi(w.y); s += (a0 * a0 + a1 * a1) + (a2 * a2 + a3 * a3); }
        s = wave_sum(s);
        if (lane < 16) rsq[(size_t)m * 16 + lane] = lane == 0 ? s : 0.f;
    }
}
DI void segnorm(bf16* buf, int ld, int rows, int nchunks, int W, const float* gainA, float scaleA, int chunksA, const float* gainB, float scaleB) {
    const int tid = otid(), lane = tid & 63, wave = tid >> 6;
    const int gw = obid() * 8 + wave, NGW = gridDim.x * 8;
    const int total = rows * nchunks, gi = (lane * 8) % W; const float invW = 1.f / (float)W; const int lim = W / 8;
    for (int it = gw; it < total; it += NGW) {
        const int row = it / nchunks, ch = it % nchunks;
        bf16* p = buf + (size_t)row * ld + ch * 512 + lane * 8;
        const u32x4 v = *(const u32x4*)p; float f[8]; unpack8(v, f);
        float s = 0.f;
#pragma unroll
        for (int i = 0; i < 8; ++i) s += f[i] * f[i];
        for (int o = 1; o < lim; o <<= 1) s += __shfl_xor(s, o);
        const float rstd = 1.f / sqrtf(s * invW + 1e-6f);
        const float* g = (ch < chunksA) ? gainA : gainB; const float sc = ((ch < chunksA) ? scaleA : scaleB) * rstd;
#pragma unroll
        for (int i = 0; i < 8; ++i) f[i] = f[i] * sc * g[gi + i];
        *(u32x4*)p = pack8u(f);
    }
}
template <int M, int N, int K, int LDA, class Epi> DI void run_gemm(unsigned char* lds, const bf16* A, const bf16* Bt, const Epi& E) {
    constexpr int lda = LDA;
    pg8::Gemm g{A, lda, Bt, M, N, K}; pg8::StaticOrder S; S.init(M, N, (int)gridDim.x, obid());
    pg8::gemm_phase<Epi, pg8::StaticOrder, true, true>((PG8_LAS unsigned char*)lds, g, S, E);
}
#define S5_FENCE() asm volatile("" ::: "memory")
DI float fma_s(float a, float b, float c) { float d; asm("v_fma_f32 %0, %1, %2, %3" : "=v"(d) : "v"(a), "v"(b), "v"(c)); return d; }
DI void s5_phase(int e, unsigned char* lds, const bf16* proj, bf16* yf, bf16* yb) {
    const KArgs& a = *kargs();
    const int tid = otid(), lane = tid & 63, wave = tid >> 6, l31 = lane & 31, hi = lane >> 5; const int G = gridDim.x;
    float* BUf = (float*)(lds + wave * 27136); unsigned char* sb = lds + wave * 27136 + 18432;
    if (wave < 4) for (int t = wave * G + obid(); t < 768; t += 4 * G) {
        int seq, rem, L, rowbase;
        if (t < 256) { seq = t >> 6; rem = t & 63; L = 4096; rowbase = seq * 4096; }
        else { const int t2 = t - 256; seq = t2 >> 6; rem = t2 & 63; L = 2048; rowbase = 16384 + seq * 2048; }
        const int g = rem >> 1, dir = rem & 1;
        const int pd = (e * 2 + dir) * 32 + g;
        const float stp = expf(a.in[12][pd]);
        float lbr, lbi;
        { const float lr = a.in[10][pd * 64 + lane], li = a.in[11][pd * 64 + lane]; const float mag = expf(lr * stp); float sn, cs; sincosf(li * stp, &sn, &cs); lbr = mag * cs; lbi = mag * sn; }
        bf16x8 bfr[4];
#pragma unroll
        for (int nb = 0; nb < 4; ++nb) { const int col = 32 * nb + l31, p = col >> 1, ri = col & 1;
            const float lr = a.in[10][pd * 64 + p], li = a.in[11][pd * 64 + p]; const float mag = expf(lr * stp); float sn, cs; sincosf(li * stp, &sn, &cs);
            const float nr0 = mag * cs - 1.f, ni0 = mag * sn, den = lr * lr + li * li;
            const float cr = (nr0 * lr + ni0 * li) / den, ci = (ni0 * lr - nr0 * li) / den;
            const f32x4* br4 = (const f32x4*)(a.in[13] + ((size_t)pd * 64 + p) * 16 + 8 * hi); const f32x4* bi4 = (const f32x4*)(a.in[14] + ((size_t)pd * 64 + p) * 16 + 8 * hi);
            float f[8];
#pragma unroll
            for (int q = 0; q < 2; ++q) { const f32x4 x = br4[q], y = bi4[q];
#pragma unroll
                for (int i = 0; i < 4; ++i) f[4 * q + i] = ri ? (cr * y[i] + ci * x[i]) : (cr * x[i] - ci * y[i]); }
            bfr[nb] = __builtin_bit_cast(bf16x8, pack8u(f)); }
        bf16x8 cf[4];
        { const int c = lane & 15, kq = lane >> 4; const float* cre = a.in[15] + ((size_t)pd * 16 + c) * 64; const float* cim = a.in[16] + ((size_t)pd * 16 + c) * 64;
#pragma unroll
          for (int s = 0; s < 4; ++s) { float f[8];
#pragma unroll
              for (int j = 0; j < 4; ++j) { const int pp = 16 * s + 4 * kq + j; f[2 * j] = cre[pp]; f[2 * j + 1] = -cim[pp]; }
              cf[s] = __builtin_bit_cast(bf16x8, pack8u(f)); } }
        float sr = 0.f, si = 0.f; const float nlbi = -lbi;
        const int NC = L / 32;
        bf16* ydst = dir ? yb : yf;
        const bf16* ubase = proj + (size_t)(rowbase + l31) * 2304 + g * 16 + 8 * hi;
        bf16x8 ua = *(const bf16x8*)(ubase + (size_t)((dir ? NC - 1 : 0) * 32) * 2304);
        for (int ci2 = 0; ci2 < NC; ++ci2) {
            const int c = dir ? NC - 1 - ci2 : ci2; const int t0 = c * 32;
#pragma unroll
            for (int nb = 0; nb < 4; ++nb) { const f32x16 d = mfma32(ua, bfr[nb], f32x16{});
#pragma unroll
                for (int j = 0; j < 4; ++j) *(f32x4*)(BUf + (32 * nb + l31) * 36 + 8 * j + 4 * hi) = (f32x4){d[4 * j], d[4 * j + 1], d[4 * j + 2], d[4 * j + 3]}; }
            S5_FENCE();
            if (ci2 + 1 < NC) { const int cn = dir ? c - 1 : c + 1; ua = *(const bf16x8*)(ubase + (size_t)(cn * 32) * 2304); }
            typedef float f32x2s __attribute__((ext_vector_type(2)));
            f32x2s bu[32];
#pragma unroll
            for (int q = 0; q < 8; ++q) { const f32x4 re4 = *(const f32x4*)(BUf + (2 * lane) * 36 + 4 * q), im4 = *(const f32x4*)(BUf + (2 * lane + 1) * 36 + 4 * q);
#pragma unroll
                for (int i = 0; i < 4; ++i) { bu[4 * q + i].x = re4[i]; bu[4 * q + i].y = im4[i]; } }
            S5_FENCE();
            if (dir == 0) {
#pragma unroll
                for (int k = 0; k < 32; ++k) { const float nr = fma_s(lbr, sr, fma_s(nlbi, si, bu[k].x)), ni = fma_s(lbr, si, fma_s(lbi, sr, bu[k].y)); sr = nr; si = ni; *(unsigned*)(sb + k * 272 + lane * 4) = pk2(sr, si); }
            } else {
#pragma unroll
                for (int k = 31; k >= 0; --k) { const float nr = fma_s(lbr, sr, fma_s(nlbi, si, bu[k].x)), ni = fma_s(lbr, si, fma_s(lbi, sr, bu[k].y)); sr = nr; si = ni; *(unsigned*)(sb + k * 272 + lane * 4) = pk2(sr, si); }
            }
            S5_FENCE();
#pragma unroll
            for (int mt = 0; mt < 2; ++mt) { f32x4 acc = (f32x4){0.f, 0.f, 0.f, 0.f};
#pragma unroll
                for (int s = 0; s < 4; ++s) { const bf16x8 av = *(const bf16x8*)(sb + (16 * mt + (lane & 15)) * 272 + (32 * s + 8 * (lane >> 4)) * 2); acc = mfma16(av, cf[s], acc); }
#pragma unroll
                for (int i = 0; i < 4; ++i) ydst[(size_t)(rowbase + t0 + 16 * mt + 4 * (lane >> 4) + i) * 512 + g * 16 + (lane & 15)] = f2b(acc[i]); }
            S5_FENCE();
        }
    }
}
DI void s5_combine(int e, bf16* proj, const bf16* yf, const bf16* yb) {
    const KArgs& a = *kargs();
    const int gid = obid() * 512 + otid(), stride = gridDim.x * 512;
    for (int it = gid; it < MTOK * 64; it += stride) {
        const int row = it >> 6, c8 = (it & 63) * 8;
        const u32x4 vf = *(const u32x4*)(yf + (size_t)row * 512 + c8), vb = *(const u32x4*)(yb + (size_t)row * 512 + c8);
        bf16* up = proj + (size_t)row * 2304 + c8; const u32x4 vu = *(const u32x4*)up;
        float f[8], b[8], u[8]; unpack8(vf, f); unpack8(vb, b); unpack8(vu, u);
        const f32x4 d0 = *(const f32x4*)(a.in[17] + e * 512 + c8), d1 = *(const f32x4*)(a.in[17] + e * 512 + c8 + 4);
#pragma unroll
        for (int i = 0; i < 8; ++i) { const float dd = i < 4 ? d0[i] : d1[i - 4]; const float y = f[i] + b[i] + dd * u[i];
            const float z = 0.7978845608028654f * (y + 0.044715f * y * y * y); const float th = 1.f - 2.f / (1.f + __expf(2.f * z)); f[i] = 0.5f * y * (1.f + th); }
        *(u32x4*)up = pack8u(f);
    }
}
constexpr int GL_CUM = 0, GL_SEGT = 33280, GL_GLR = 35328, GL_VT = 43520, GL_A = 61952, GL_B = 80384, GL_C = 98816, GL_RS = 117248, CS = 65;
DI float logsig(float x) { return fminf(x, 0.f) - __logf(1.f + __expf(-fabsf(x))); }
DI void gla_cumsum(int e, int h, unsigned char* lds, const u32x2 glr_pre) {
    const KArgs& a = *kargs();
    const int tid = otid();
    float* cumS = (float*)(lds + GL_CUM); float* glrS = (float*)(lds + GL_GLR); float* segT = (float*)(lds + GL_SEGT);
    { const int r = tid >> 3, c4 = (tid & 7) * 4; const u32x2 v = glr_pre;
      *(f32x4*)(glrS + r * 32 + c4) = (f32x4){bflo(v.x), bfhi(v.x), bflo(v.y), bfhi(v.y)}; }
    __syncthreads();
    const int z = tid >> 8, seg = (tid >> 6) & 3, d = tid & 63;
    float c[16];
    { float w[16];
#pragma unroll
      for (int r = 0; r < 16; ++r) w[r] = a.in[19][((size_t)(e * 2 + z) * 16 + r) * 256 + h * 64 + d];
      const float b = a.in[20][(e * 2 + z) * 256 + h * 64 + d]; float cum = 0.f;
#pragma unroll
      for (int k = 0; k < 16; k += 2) {
          const int ta = z ? 16 * seg + 15 - k : 16 * seg + k, tb = z ? ta - 1 : ta + 1;
          const f32x4* pa = (const f32x4*)(glrS + ta * 32 + z * 16); const f32x4* pb = (const f32x4*)(glrS + tb * 32 + z * 16);
          const f32x4 a0 = pa[0], a1 = pa[1], a2 = pa[2], a3 = pa[3], b0 = pb[0], b1 = pb[1], b2 = pb[2], b3 = pb[3];
          float lga = b, lgb = b;
          lga += a0[0] * w[0] + a0[1] * w[1] + a0[2] * w[2] + a0[3] * w[3]; lga += a1[0] * w[4] + a1[1] * w[5] + a1[2] * w[6] + a1[3] * w[7];
          lga += a2[0] * w[8] + a2[1] * w[9] + a2[2] * w[10] + a2[3] * w[11]; lga += a3[0] * w[12] + a3[1] * w[13] + a3[2] * w[14] + a3[3] * w[15];
          lgb += b0[0] * w[0] + b0[1] * w[1] + b0[2] * w[2] + b0[3] * w[3]; lgb += b1[0] * w[4] + b1[1] * w[5] + b1[2] * w[6] + b1[3] * w[7];
          lgb += b2[0] * w[8] + b2[1] * w[9] + b2[2] * w[10] + b2[3] * w[11]; lgb += b3[0] * w[12] + b3[1] * w[13] + b3[2] * w[14] + b3[3] * w[15];
          cum += logsig(lga) * (1.f / 16.f); c[k] = cum; cum += logsig(lgb) * (1.f / 16.f); c[k + 1] = cum; }
      segT[(z * 4 + seg) * 64 + d] = cum; }
    __syncthreads();
    { float pre = 0.f;
#pragma unroll
      for (int s2 = 0; s2 < 4; ++s2) { const bool before = z ? (s2 > seg) : (s2 < seg); const float v = segT[(z * 4 + s2) * 64 + d]; pre += before ? v : 0.f; }
#pragma unroll
      for (int k = 0; k < 16; ++k) { const int t = z ? 16 * seg + 15 - k : 16 * seg + k; cumS[(z * 64 + t) * CS + d] = c[k] + pre; } }
    __syncthreads();
}
DI void gla_stage_vt(unsigned char* lds, const u32x4 v0, const u32x4 v1) {
    const int tid = otid(), j = tid & 63, ec = (tid >> 6) * 16; bf16* Vt = (bf16*)(lds + GL_VT);
    const unsigned w[8] = {v0.x, v0.y, v0.z, v0.w, v1.x, v1.y, v1.z, v1.w};
#pragma unroll
    for (int i = 0; i < 8; ++i) { Vt[(ec + 2 * i) * 72 + j] = (bf16)(w[i] & 0xffffu); Vt[(ec + 2 * i + 1) * 72 + j] = (bf16)(w[i] >> 16); }
}
DI void gla_g1(int e, unsigned char* lds, const bf16* proj, bf16* kvbuf, float* dec) {
    const KArgs& a = *kargs();
    const int tid = otid(), lane = tid & 63, wave = tid >> 6, l31 = lane & 31, hi = lane >> 5;
    const float* cumS = (const float*)(lds + GL_CUM); bf16* Vt = (bf16*)(lds + GL_VT); bf16* KoT = (bf16*)(lds + GL_A);
#define GLA_PRE(T_, GL_, K_, V0_, V1_) do { const int n_ = (T_) >> 2, h_ = (T_) & 3; const bf16* rb_ = proj + (size_t)(n_ * 64) * 2304; \
        GL_ = *(const u32x2*)(rb_ + (size_t)(tid >> 3) * 2304 + 2048 + (tid & 7) * 4); K_ = *(const u32x4*)(rb_ + (size_t)(tid & 63) * 2304 + 768 + h_ * 64 + (tid >> 6) * 8); \
        const bf16* vp_ = rb_ + (size_t)(tid & 63) * 2304 + 1024 + h_ * 128 + (tid >> 6) * 16; V0_ = *(const u32x4*)vp_; V1_ = *(const u32x4*)(vp_ + 8); } while (0)
    u32x2 nglr = (u32x2){0u, 0u}; u32x4 nk = (u32x4){0u, 0u, 0u, 0u}, nv0 = nk, nv1 = nk;
    if (obid() < 2048) GLA_PRE(obid(), nglr, nk, nv0, nv1);
    for (int task = obid(); task < 2048; task += gridDim.x) {
        const int n = task >> 2, h = task & 3, row0 = n * 64; (void)row0; (void)n;
        const u32x2 cglr = nglr; const u32x4 kv = nk, cv0 = nv0, cv1 = nv1;
        if (task + (int)gridDim.x < 2048) GLA_PRE(task + (int)gridDim.x, nglr, nk, nv0, nv1);
        gla_cumsum(e, h, lds, cglr);
        { const int j = tid & 63, dc = (tid >> 6) * 8; float kf[8]; unpack8(kv, kf);
#pragma unroll
          for (int z = 0; z < 2; ++z)
#pragma unroll
              for (int i = 0; i < 8; ++i) { const int d = dc + i; const float tot = cumS[(z * 64 + (z ? 0 : 63)) * CS + d];
                  KoT[(z * 64 + d) * 72 + j] = f2b(kf[i] * __expf(tot - cumS[(z * 64 + j) * CS + d])); } }
        gla_stage_vt(lds, cv0, cv1);
        __syncthreads();
        { const int z = wave >> 2, eb = wave & 3; f32x16 acc[2]; acc[0] = f32x16{}; acc[1] = f32x16{};
#pragma unroll
          for (int s = 0; s < 4; ++s) { const bf16x8 av = *(const bf16x8*)(Vt + (32 * eb + l31) * 72 + 16 * s + 8 * hi);
#pragma unroll
              for (int nb = 0; nb < 2; ++nb) { const bf16x8 bv = *(const bf16x8*)(KoT + (z * 64 + 32 * nb + l31) * 72 + 16 * s + 8 * hi); acc[nb] = mfma32(av, bv, acc[nb]); } }
          bf16* dst = kvbuf + ((size_t)(task * 2 + z) * 128 + 32 * eb) * 64 + l31;
#pragma unroll
          for (int nb = 0; nb < 2; ++nb)
#pragma unroll
              for (int r = 0; r < 16; ++r) dst[crow(r, hi) * 64 + 32 * nb] = f2b(acc[nb][r]); }
        if (tid < 128) { const int z = tid >> 6, d = tid & 63; dec[(size_t)(task * 2 + z) * 64 + d] = __expf(cumS[(z * 64 + (z ? 0 : 63)) * CS + d]); }
        __syncthreads();
    }
}
DI void gla_g2(bf16* kvbuf, const float* dec) {
    const int gid = obid() * 512 + otid(), stride = gridDim.x * 512;
    for (int it = gid; it < 98304; it += stride) {
        const int dc = it & 7, ee = (it >> 3) & 127, z = (it >> 10) & 1, sh = it >> 11, seq = sh >> 2, h = sh & 3;
        const int chunk0 = seq < 4 ? seq * 64 : 256 + (seq - 4) * 32, NC = seq < 4 ? 64 : 32;
        float S[8];
#pragma unroll
        for (int i = 0; i < 8; ++i) S[i] = 0.f;
        for (int ci = 0; ci < NC; ++ci) { const int c = z ? NC - 1 - ci : ci; const int task = (chunk0 + c) * 4 + h;
            bf16* p = kvbuf + ((size_t)(task * 2 + z) * 128 + ee) * 64 + dc * 8; const u32x4 kvv = *(const u32x4*)p; float kv[8]; unpack8(kvv, kv);
            const float* dp = dec + (size_t)(task * 2 + z) * 64 + dc * 8; const f32x4 d0 = *(const f32x4*)dp, d1 = *(const f32x4*)(dp + 4);
            *(u32x4*)p = pack8u(S);
#pragma unroll
            for (int i = 0; i < 8; ++i) S[i] = (i < 4 ? d0[i] : d1[i - 4]) * S[i] + kv[i]; }
    }
}
DI void gla_g3(int e, unsigned char* lds, const bf16* proj, const bf16* kvbuf, bf16* ycat) {
    const KArgs& a = *kargs();
    const int tid = otid(), lane = tid & 63, wave = tid >> 6, l31 = lane & 31, hi = lane >> 5;
    const float* cumS = (const float*)(lds + GL_CUM); bf16* Vt = (bf16*)(lds + GL_VT);
    bf16* Qrel = (bf16*)(lds + GL_A); bf16* Krel = (bf16*)(lds + GL_B); bf16* Qd = (bf16*)(lds + GL_C); float* rs = (float*)(lds + GL_RS);
#define GLA_PRE3(T_, GL_, Q_, K_, V0_, V1_) do { const int n_ = (T_) >> 2, h_ = (T_) & 3; const bf16* rb_ = proj + (size_t)(n_ * 64) * 2304; \
        GL_ = *(const u32x2*)(rb_ + (size_t)(tid >> 3) * 2304 + 2048 + (tid & 7) * 4); const bf16* rp_ = rb_ + (size_t)(tid >> 3) * 2304 + h_ * 64 + (tid & 7) * 8; Q_ = *(const u32x4*)(rp_ + 512); K_ = *(const u32x4*)(rp_ + 768); \
        const bf16* vp_ = rb_ + (size_t)(tid & 63) * 2304 + 1024 + h_ * 128 + (tid >> 6) * 16; V0_ = *(const u32x4*)vp_; V1_ = *(const u32x4*)(vp_ + 8); } while (0)
    u32x2 nglr = (u32x2){0u, 0u}; u32x4 nq = (u32x4){0u, 0u, 0u, 0u}, nk = nq, nv0 = nq, nv1 = nq;
    if (obid() < 2048) GLA_PRE3(obid(), nglr, nq, nk, nv0, nv1);
    for (int task = obid(); task < 2048; task += gridDim.x) {
        const int n = task >> 2, h = task & 3, row0 = n * 64;
        const u32x2 cglr = nglr; const u32x4 qv = nq, kv = nk, cv0 = nv0, cv1 = nv1;
        if (task + (int)gridDim.x < 2048) GLA_PRE3(task + (int)gridDim.x, nglr, nq, nk, nv0, nv1);
        gla_cumsum(e, h, lds, cglr);
        { const int j = tid >> 3, dc = (tid & 7) * 8;
          float qf[8], kf[8]; unpack8(qv, qf); unpack8(kv, kf);
#pragma unroll
          for (int z = 0; z < 2; ++z) { float o1[8], o2[8], o3[8];
#pragma unroll
              for (int i = 0; i < 8; ++i) { const int d = dc + i; const float cj = cumS[(z * 64 + j) * CS + d], rf = cumS[(z * 64 + (z ? 32 : 31)) * CS + d]; const float q8 = qf[i] * 0.125f;
                  o1[i] = q8 * __expf(cj - rf); o2[i] = kf[i] * __expf(rf - cj); o3[i] = q8 * __expf(cj); }
              *(u32x4*)(Qrel + (z * 64 + j) * 72 + dc) = pack8u(o1); *(u32x4*)(Krel + (z * 64 + j) * 72 + dc) = pack8u(o2); *(u32x4*)(Qd + (z * 64 + j) * 72 + dc) = pack8u(o3); } }
        gla_stage_vt(lds, cv0, cv1);
        const int ib = wave >> 2, eb = wave & 3; f32x16 acc = f32x16{};
        bf16x8 bsr[2][4];
#pragma unroll
        for (int z = 0; z < 2; ++z)
#pragma unroll
            for (int s = 0; s < 4; ++s) bsr[z][s] = *(const bf16x8*)(kvbuf + ((size_t)(task * 2 + z) * 128 + 32 * eb + l31) * 64 + 16 * s + 8 * hi);
        unsigned short ogr[16];
#pragma unroll
        for (int r = 0; r < 16; ++r) ogr[r] = proj[(size_t)(row0 + 32 * ib + crow(r, hi)) * 2304 + 1536 + h * 128 + 32 * eb + l31];
        __syncthreads();
#pragma unroll
        for (int z = 0; z < 2; ++z) {
            f32x16 st[2]; st[0] = f32x16{}; st[1] = f32x16{};
#pragma unroll
            for (int s = 0; s < 4; ++s) { const bf16x8 bq = *(const bf16x8*)(Qrel + (z * 64 + 32 * ib + l31) * 72 + 16 * s + 8 * hi);
#pragma unroll
                for (int jb = 0; jb < 2; ++jb) { const bf16x8 ak = *(const bf16x8*)(Krel + (z * 64 + 32 * jb + l31) * 72 + 16 * s + 8 * hi); st[jb] = mfma32(ak, bq, st[jb]); } }
            const int i = 32 * ib + l31;
#pragma unroll
            for (int jb = 0; jb < 2; ++jb)
#pragma unroll
                for (int r = 0; r < 16; ++r) { const int j = 32 * jb + crow(r, hi); const bool keep = z ? (j >= i) : (j <= i); st[jb][r] = keep ? st[jb][r] : 0.f; }
#pragma unroll
            for (int jb = 0; jb < 2; ++jb)
#pragma unroll
                for (int s2 = 0; s2 < 2; ++s2) { float pf[8];
#pragma unroll
                    for (int q = 0; q < 8; ++q) pf[q] = st[jb][8 * s2 + q];
                    const bf16* vp = Vt + (32 * eb + l31) * 72 + 32 * jb + 16 * s2 + 4 * hi; const u32x2 lo = *(const u32x2*)vp, hi8 = *(const u32x2*)(vp + 8);
                    const u32x4 bw = (u32x4){lo.x, lo.y, hi8.x, hi8.y};
                    acc = mfma32(__builtin_bit_cast(bf16x8, pack8u(pf)), __builtin_bit_cast(bf16x8, bw), acc); }
#pragma unroll
            for (int s = 0; s < 4; ++s) { const bf16x8 aq = *(const bf16x8*)(Qd + (z * 64 + 32 * ib + l31) * 72 + 16 * s + 8 * hi);
                acc = mfma32(aq, bsr[z][s], acc); }
        }
        float sq[16];
#pragma unroll
        for (int r = 0; r < 16; ++r) { float v = acc[r] * acc[r]; v += __shfl_xor(v, 1); v += __shfl_xor(v, 2); v += __shfl_xor(v, 4); v += __shfl_xor(v, 8); v += __shfl_xor(v, 16); sq[r] = v; }
        if (l31 == 0) {
#pragma unroll
            for (int r = 0; r < 16; ++r) rs[wave * 32 + crow(r, hi)] = sq[r]; }
        __syncthreads();
        { const int ecol = h * 128 + 32 * eb + l31; const float gn = a.in[21][e * 128 + 32 * eb + l31];
#pragma unroll
          for (int r = 0; r < 16; ++r) { const int il = crow(r, hi); const float tot = rs[(ib * 4 + 0) * 32 + il] + rs[(ib * 4 + 1) * 32 + il] + rs[(ib * 4 + 2) * 32 + il] + rs[(ib * 4 + 3) * 32 + il];
              const float rstd = 1.f / sqrtf(tot * (1.f / 128.f) + 1e-6f); const size_t row = (size_t)(row0 + 32 * ib + il);
              const float og = bflo((unsigned)ogr[r]); const float sl = og / (1.f + __expf(-og));
              ycat[row * 1024 + 512 + ecol] = f2b(acc[r] * rstd * gn * sl); } }
        __syncthreads();
    }
}
template <bool DIFF>
DI void attn_unit(unsigned char* lds, const bf16* Qb, int ldq, const bf16* Kb, int ldk, const bf16* Vb, int ldv, int nkeys,
                  bf16* Ob, int ldo, int qpos0, float slope2, float negSB2, float lam, const float* sub_gain, float outscale) {
    constexpr int DK = DIFF ? 64 : 256, KW = DIFF ? 128 : 256, DVT = DIFF ? 128 : 256, KS = KW + 8, VS = 72, NS = DK / 16;
    constexpr int KCH = KW / 8, VCH = DVT / 8, NKL = 64 * KCH / 512, NVL = 64 * VCH / 512;
    bf16* Ks = (bf16*)lds; bf16* Vt = (bf16*)(lds + 34816); float* EX = (float*)lds;
    const int tid = otid(), lane = tid & 63, wave = tid >> 6, l31 = lane & 31, hi = lane >> 5, qg = wave & 3, sel = wave >> 2;
    const int kcol = DIFF ? sel * 64 : 0, vrow0 = DIFF ? 0 : sel * 128;
    bf16x8 qf[NS];
    { const bf16* qp = Qb + (size_t)(qg * 32 + l31) * ldq + kcol + 8 * hi;
#pragma unroll
      for (int s = 0; s < NS; ++s) qf[s] = *(const bf16x8*)(qp + 16 * s); }
    f32x16 O[4];
#pragma unroll
    for (int nb = 0; nb < 4; ++nb) O[nb] = f32x16{};
    float lsum = 0.f;
    const int NT = nkeys / 64;
    const float qposf = (float)(qpos0 + qg * 32 + l31);
    u32x4 kreg[NKL], vreg[NVL];
#define ATT_LOAD(t) do { \
    _Pragma("unroll") for (int i_ = 0; i_ < NKL; ++i_) { const int c_ = tid + i_ * 512, row_ = c_ / KCH, cc_ = c_ % KCH; kreg[i_] = *(const u32x4*)(Kb + (size_t)((t) * 64 + row_) * ldk + cc_ * 8); } \
    _Pragma("unroll") for (int i_ = 0; i_ < NVL; ++i_) { const int c_ = tid + i_ * 512, row_ = c_ / VCH, cc_ = c_ % VCH; vreg[i_] = *(const u32x4*)(Vb + (size_t)((t) * 64 + row_) * ldv + cc_ * 8); } } while (0)
    if (DIFF) ATT_LOAD(0);
    for (int t = 0; t < NT; ++t) {
        if (!DIFF) ATT_LOAD(t);
#pragma unroll
        for (int i = 0; i < NKL; ++i) { const int c = tid + i * 512, row = c / KCH, cc = c % KCH; *(u32x4*)(Ks + row * KS + cc * 8) = kreg[i]; }
#pragma unroll
        for (int i = 0; i < NVL; ++i) { const int c = tid + i * 512, row = c / VCH, cc = c % VCH; const unsigned w[4] = {vreg[i].x, vreg[i].y, vreg[i].z, vreg[i].w};
#pragma unroll
            for (int q = 0; q < 4; ++q) { Vt[(cc * 8 + 2 * q) * VS + row] = (bf16)(w[q] & 0xffffu); Vt[(cc * 8 + 2 * q + 1) * VS + row] = (bf16)(w[q] >> 16); } }
        __syncthreads();
        if (DIFF && t + 1 < NT) ATT_LOAD(t + 1);
        f32x16 st[2];
#pragma unroll
        for (int r = 0; r < 16; ++r) { st[0][r] = negSB2; st[1][r] = negSB2; }
#pragma unroll
        for (int s = 0; s < NS; ++s)
#pragma unroll
            for (int kb = 0; kb < 2; ++kb) { const bf16x8 av = *(const bf16x8*)(Ks + (32 * kb + l31) * KS + kcol + 16 * s + 8 * hi); st[kb] = mfma32(av, qf[s], st[kb]); }
        bf16x8 pf[2][2];
#pragma unroll
        for (int kb = 0; kb < 2; ++kb) {
            const float base = qposf - (float)(t * 64 + 32 * kb + 4 * hi);
            float p[16];
#pragma unroll
            for (int r = 0; r < 16; ++r) { float x = st[kb][r];
                if (DIFF) { const float dl = base - (float)((r & 3) + 8 * (r >> 2)); x = x - slope2 * fabsf(dl); }
                p[r] = __builtin_amdgcn_exp2f(x); lsum += p[r]; }
            pf[kb][0] = __builtin_bit_cast(bf16x8, pack8u(p)); pf[kb][1] = __builtin_bit_cast(bf16x8, pack8u(p + 8));
        }
#pragma unroll
        for (int nb = 0; nb < 4; ++nb)
#pragma unroll
            for (int kb = 0; kb < 2; ++kb)
#pragma unroll
                for (int s2 = 0; s2 < 2; ++s2) { const bf16* vp = Vt + (vrow0 + 32 * nb + l31) * VS + 32 * kb + 16 * s2 + 4 * hi; const u32x2 lo = *(const u32x2*)vp, hi8 = *(const u32x2*)(vp + 8);
                    const u32x4 bw = (u32x4){lo.x, lo.y, hi8.x, hi8.y}; O[nb] = mfma32(pf[kb][s2], __builtin_bit_cast(bf16x8, bw), O[nb]); }
        __syncthreads();
    }
#undef ATT_LOAD
    lsum += __shfl_xor(lsum, 32);
    float invl[16];
#pragma unroll
    for (int r = 0; r < 16; ++r) invl[r] = 1.f / __shfl(lsum, crow(r, hi));
#pragma unroll
    for (int nb = 0; nb < 4; ++nb)
#pragma unroll
        for (int r = 0; r < 16; ++r) O[nb][r] *= invl[r];
    if (DIFF) {
        if (sel == 1) {
#pragma unroll
            for (int nb = 0; nb < 4; ++nb)
#pragma unroll
                for (int r = 0; r < 16; ++r) EX[((qg * 4 + nb) * 16 + r) * 64 + lane] = O[nb][r]; }
        __syncthreads();
        if (sel == 0) {
            float sq[16];
#pragma unroll
            for (int r = 0; r < 16; ++r) sq[r] = 0.f;
#pragma unroll
            for (int nb = 0; nb < 4; ++nb)
#pragma unroll
                for (int r = 0; r < 16; ++r) { const float v = O[nb][r] - lam * EX[((qg * 4 + nb) * 16 + r) * 64 + lane]; O[nb][r] = v; sq[r] += v * v; }
#pragma unroll
            for (int r = 0; r < 16; ++r) { float v = sq[r]; v += __shfl_xor(v, 1); v += __shfl_xor(v, 2); v += __shfl_xor(v, 4); v += __shfl_xor(v, 8); v += __shfl_xor(v, 16);
                sq[r] = outscale / sqrtf(v * (1.f / 128.f) + 1e-6f); }
#pragma unroll
            for (int nb = 0; nb < 4; ++nb) { const float gn = sub_gain[32 * nb + l31];
#pragma unroll
                for (int r = 0; r < 16; ++r) Ob[(size_t)(qg * 32 + crow(r, hi)) * ldo + 32 * nb + l31] = f2b(O[nb][r] * sq[r] * gn); }
        }
        __syncthreads();
    } else {
#pragma unroll
        for (int nb = 0; nb < 4; ++nb)
#pragma unroll
            for (int r = 0; r < 16; ++r) Ob[(size_t)(qg * 32 + crow(r, hi)) * ldo + sel * 128 + 32 * nb + l31] = f2b(O[nb][r]);
    }
}
DI void diff_attn_phase(int o, int layer, unsigned char* lds, bf16* QKV, bf16* dummyO) {
    const KArgs& a = *kargs();
    const int lane = otid() & 63;
    const float gq = wave_max(fabsf(a.in[24][o * 64 + lane])), gk = wave_max(fabsf(a.in[25][o * 64 + lane]));
    const float negSB2 = -(8.f * gq * gk * 1.02f + 0.5f) * LOG2E;
    const float d1 = wave_sum(a.in[26][o * 64 + lane] * a.in[27][o * 64 + lane]), d2 = wave_sum(a.in[28][o * 64 + lane] * a.in[29][o * 64 + lane]);
    const float lambda_init = 0.8f - 0.6f * expf(-0.3f * (float)layer);
    const float lam = expf(d1) - expf(d2) + lambda_init;
    for (int u = obid(); u < 2048; u += gridDim.x) {
        int head, qb, L, rowbase;
        if (u < 1024) { const int seq = u >> 8, rem = u & 255; head = rem >> 5; qb = rem & 31; L = 4096; rowbase = seq * 4096; }
        else { const int u2 = u - 1024, seq = u2 >> 7, rem = u2 & 127; head = rem >> 4; qb = rem & 15; L = 2048; rowbase = 16384 + seq * 2048; }
        bf16* Qb = QKV + (size_t)(rowbase + qb * 128) * 3072 + head * 128;
        const bf16* Kb = QKV + (size_t)rowbase * 3072 + 1024 + head * 128; const bf16* Vb = QKV + (size_t)rowbase * 3072 + 2048 + head * 128;
        const float slope2 = exp2f(-(float)(head + 1)) * LOG2E;
        bf16* Od = dummyO ? dummyO + (size_t)(rowbase + qb * 128) * 1024 + head * 128 : Qb;
        attn_unit<true>(lds, Qb, 3072, Kb, 3072, Vb, 3072, L, Od, dummyO ? 1024 : 3072, qb * 128, slope2, negSB2, lam, a.in[30] + o * 128, 1.f - lambda_init);
    }
}
DI void cross_attn_phase(int layer, unsigned char* lds, bf16* qx, const bf16* kvx, bf16* dummyO) {
    const KArgs& a = *kargs();
    const int lane = otid() & 63;
    float gq = 0.f, gk = 0.f;
#pragma unroll
    for (int i = 0; i < 4; ++i) { gq = fmaxf(gq, fabsf(a.in[34][layer * 256 + lane + 64 * i])); gk = fmaxf(gk, fabsf(a.in[35][layer * 256 + lane + 64 * i])); }
    gq = wave_max(gq); gk = wave_max(gk);
    const float negSB2 = -(16.f * gq * gk * 1.02f + 0.5f) * LOG2E;
    for (int u = obid(); u < 1024; u += gridDim.x) {
        const int rb = u >> 2, head = u & 3, row0 = rb * 128; const int seq = row0 < 16384 ? (row0 >> 12) : 4 + ((row0 - 16384) >> 11);
        bf16* Qb = qx + (size_t)row0 * 1024 + head * 256; const bf16* Kb = kvx + (size_t)(seq * 256) * 2048 + head * 256; const bf16* Vb = Kb + 1024;
        bf16* Od = dummyO ? dummyO + (size_t)row0 * 1024 + head * 256 : Qb;
        attn_unit<false>(lds, Qb, 1024, Kb, 2048, Vb, 2048, 256, Od, 1024, 0, 0.f, negSB2, 0.f, nullptr, 1.f);
    }
}
DI void vt_prep(unsigned char* lds, const bf16* QKV, bf16* VT) {
    const int tid = otid(); bf16* T = (bf16*)lds;
    for (int item = obid(); item < 4096; item += gridDim.x) {
        const int n = item >> 3, head = item & 7, row0 = n * 64;
        int rowbase, L; if (row0 < 16384) { rowbase = row0 & ~4095; L = 4096; } else { rowbase = 16384 + ((row0 - 16384) & ~2047); L = 2048; }
        const int t0 = row0 - rowbase;
#pragma unroll
        for (int i = 0; i < 2; ++i) { const int c = tid + i * 512, r = c >> 4, cc = c & 15;
            *(u32x4*)(T + r * 136 + cc * 8) = *(const u32x4*)(QKV + (size_t)(row0 + r) * 3072 + 2048 + head * 128 + cc * 8); }
        __syncthreads();
        { const int e = tid >> 2, tq = (tid & 3) * 16; unsigned w[8];
#pragma unroll
          for (int i = 0; i < 8; ++i) w[i] = (unsigned)T[(tq + 2 * i) * 136 + e] | ((unsigned)T[(tq + 2 * i + 1) * 136 + e] << 16);
          bf16* dst = VT + (size_t)rowbase * 1024 + (size_t)(head * 128 + e) * L + t0 + tq;
          *(u32x4*)dst = (u32x4){w[0], w[1], w[4], w[5]}; *(u32x4*)(dst + 8) = (u32x4){w[2], w[3], w[6], w[7]}; }
        __syncthreads();
    }
}
DI void diff_unit2(unsigned char* lds, const bf16* Qb, const bf16* Kb, const bf16* VTb, int L, int kt0, int kt1,
                   bf16* Ob, int qpos0, float slope2, float negSB2, float lam, const float* sub_gain, float outscale) {
    constexpr int KS = 136, VS = 72, KBUF = 64 * KS * 2  , VBUF = 128 * VS * 2  , VOFF = 2 * KBUF;
    float* EX = (float*)lds;
    const int tid = otid(), lane = tid & 63, wave = tid >> 6, l31 = lane & 31, hi = lane >> 5, qg = wave & 3, sel = wave >> 2;
    const int kcol = sel * 64;
    bf16x8 qf[4];
    { const bf16* qp = Qb + (size_t)(qg * 32 + l31) * 3072 + kcol + 8 * hi;
#pragma unroll
      for (int s = 0; s < 4; ++s) qf[s] = *(const bf16x8*)(qp + 16 * s); }
    f32x16 O[4];
#pragma unroll
    for (int nb = 0; nb < 4; ++nb) O[nb] = f32x16{};
    float lsum = 0.f;
    const float qposf = (float)(qpos0 + qg * 32 + l31);
    const int kr0 = tid >> 4, kc0 = (tid & 15) * 8, ve0 = tid >> 3, vc0 = (tid & 7) * 8;
    const bf16* kg = Kb + (size_t)kr0 * 3072 + kc0; const bf16* vg = VTb + (size_t)ve0 * L + vc0;
    u32x4 kreg[2], vreg[2];
#define D2_LOAD(t) do { kreg[0] = *(const u32x4*)(kg + (size_t)((t) * 64) * 3072); kreg[1] = *(const u32x4*)(kg + (size_t)((t) * 64 + 32) * 3072); \
                        vreg[0] = *(const u32x4*)(vg + (t) * 64); vreg[1] = *(const u32x4*)(vg + (size_t)64 * L + (t) * 64); } while (0)
#define D2_STORE(b) do { bf16* ks_ = (bf16*)(lds + (b) * KBUF); bf16* vs_ = (bf16*)(lds + VOFF + (b) * VBUF); \
                         *(u32x4*)(ks_ + kr0 * KS + kc0) = kreg[0]; *(u32x4*)(ks_ + (kr0 + 32) * KS + kc0) = kreg[1]; \
                         *(u32x4*)(vs_ + ve0 * VS + vc0) = vreg[0]; *(u32x4*)(vs_ + (ve0 + 64) * VS + vc0) = vreg[1]; } while (0)
    D2_LOAD(kt0); D2_STORE(0);
    __syncthreads();
    for (int t = kt0; t < kt1; ++t) {
        const int b = (t - kt0) & 1;
        if (t + 1 < kt1) D2_LOAD(t + 1);
        const bf16* Ks = (const bf16*)(lds + b * KBUF); const bf16* Vt = (const bf16*)(lds + VOFF + b * VBUF);
        bf16x8 kf[4][2];
#pragma unroll
        for (int s = 0; s < 4; ++s)
#pragma unroll
            for (int kb = 0; kb < 2; ++kb) kf[s][kb] = *(const bf16x8*)(Ks + (32 * kb + l31) * KS + kcol + 16 * s + 8 * hi);
        f32x16 st[2];
#pragma unroll
        for (int r = 0; r < 16; ++r) { st[0][r] = negSB2; st[1][r] = negSB2; }
        __builtin_amdgcn_sched_barrier(0);
#pragma unroll
        for (int s = 0; s < 4; ++s)
#pragma unroll
            for (int kb = 0; kb < 2; ++kb) st[kb] = mfma32(kf[s][kb], qf[s], st[kb]);
        u32x4 vA[4], vB[4];
#define D2_VLD(dst, nb) do { _Pragma("unroll") for (int q_ = 0; q_ < 4; ++q_) dst[q_] = *(const u32x4*)(Vt + (32 * (nb) + l31) * VS + 32 * (q_ >> 1) + 16 * (q_ & 1) + 8 * hi); } while (0)
#define D2_VMM(src, nb) do { _Pragma("unroll") for (int q_ = 0; q_ < 4; ++q_) O[nb] = mfma32(pf[q_ >> 1][q_ & 1], __builtin_bit_cast(bf16x8, src[q_]), O[nb]); } while (0)
        D2_VLD(vA, 0);
        bf16x8 pf[2][2];
#pragma unroll
        for (int kb = 0; kb < 2; ++kb) {
            const float base = qposf - (float)(t * 64 + 32 * kb + 4 * hi);
            float p[16];
#pragma unroll
            for (int r = 0; r < 16; ++r) { const float dl = base - (float)((r & 3) + 8 * (r >> 2)); p[r] = __builtin_amdgcn_exp2f(st[kb][r] - slope2 * fabsf(dl)); lsum += p[r]; }
            pf[kb][0] = __builtin_bit_cast(bf16x8, pack8u(p)); pf[kb][1] = __builtin_bit_cast(bf16x8, pack8u(p + 8));
        }
        __builtin_amdgcn_sched_barrier(0);
        D2_VLD(vB, 1); D2_VMM(vA, 0);
        __builtin_amdgcn_sched_barrier(0);
        D2_VLD(vA, 2); D2_VMM(vB, 1);
        __builtin_amdgcn_sched_barrier(0);
        D2_VLD(vB, 3); D2_VMM(vA, 2);
        __builtin_amdgcn_sched_barrier(0);
        D2_VMM(vB, 3);
#undef D2_VLD
#undef D2_VMM
        if (t + 1 < kt1) D2_STORE(b ^ 1);
        __syncthreads();
    }
#undef D2_LOAD
#undef D2_STORE
    lsum += __shfl_xor(lsum, 32);
    float invl[16];
#pragma unroll
    for (int r = 0; r < 16; ++r) invl[r] = 1.f / __shfl(lsum, crow(r, hi));
#pragma unroll
    for (int nb = 0; nb < 4; ++nb)
#pragma unroll
        for (int r = 0; r < 16; ++r) O[nb][r] *= invl[r];
    if (sel == 1) {
#pragma unroll
        for (int nb = 0; nb < 4; ++nb)
#pragma unroll
            for (int r = 0; r < 16; ++r) EX[((qg * 4 + nb) * 16 + r) * 64 + lane] = O[nb][r]; }
    __syncthreads();
    if (sel == 0) {
        float sq[16];
#pragma unroll
        for (int r = 0; r < 16; ++r) sq[r] = 0.f;
#pragma unroll
        for (int nb = 0; nb < 4; ++nb)
#pragma unroll
            for (int r = 0; r < 16; ++r) { const float v = O[nb][r] - lam * EX[((qg * 4 + nb) * 16 + r) * 64 + lane]; O[nb][r] = v; sq[r] += v * v; }
#pragma unroll
        for (int r = 0; r < 16; ++r) { float v = sq[r]; v += __shfl_xor(v, 1); v += __shfl_xor(v, 2); v += __shfl_xor(v, 4); v += __shfl_xor(v, 8); v += __shfl_xor(v, 16);
            sq[r] = outscale / sqrtf(v * (1.f / 128.f) + 1e-6f); }
#pragma unroll
        for (int nb = 0; nb < 4; ++nb) { const float gn = sub_gain[32 * nb + l31];
#pragma unroll
            for (int r = 0; r < 16; ++r) Ob[(size_t)(qg * 32 + crow(r, hi)) * 3072 + 32 * nb + l31] = f2b(O[nb][r] * sq[r] * gn); }
    }
    __syncthreads();
}
DI void diff_attn_phase2(int o, int layer, unsigned char* lds, bf16* QKV, const bf16* VT) {
    const KArgs& a = *kargs();
    const int lane = otid() & 63;
    const float gq = wave_max(fabsf(a.in[24][o * 64 + lane])), gk = wave_max(fabsf(a.in[25][o * 64 + lane]));
    const float SB2 = (8.f * gq * gk * 1.02f + 0.5f) * LOG2E;
    const float d1 = wave_sum(a.in[26][o * 64 + lane] * a.in[27][o * 64 + lane]), d2 = wave_sum(a.in[28][o * 64 + lane] * a.in[29][o * 64 + lane]);
    const float lambda_init = 0.8f - 0.6f * expf(-0.3f * (float)layer);
    const float lam = expf(d1) - expf(d2) + lambda_init;
    for (int b = obid(); b < 256; b += gridDim.x)
    for (int i = 0; i < 8; ++i) { const int hb = b >> 5;
        int head, qb, L, rowbase;
        if (i < 4) { const int el = (i + (hb >> 1)) & 3; const int tA = (0x4370 >> (4 * el)) & 15, tB = (0x5261 >> (4 * el)) & 15;
            head = (hb & 1) ? tB : tA; qb = b & 31; L = 4096; rowbase = i * 4096; }
        else { const int j = i - 4, sb = (b >> 4) & 15; const int el = (j + (hb >> 1)) & 3; const int tA = (0x4370 >> (4 * el)) & 15, tB = (0x5261 >> (4 * el)) & 15;
            head = (hb & 1) ? tA : tB; qb = b & 15; L = 2048; rowbase = 16384 + (2 * j + (sb & 1)) * 2048; }
        const float slope2 = exp2f(-(float)(head + 1)) * LOG2E;
        const int dmin = (int)((2.f * SB2 + 40.f) / slope2) + 1;
        const int q0 = qb * 128;
        int kt0 = (q0 - dmin) / 64; if (q0 - dmin < 0) kt0 = 0;
        int kt1 = (q0 + 127 + dmin) / 64 + 1; if (kt1 > L / 64) kt1 = L / 64;
        bf16* Qb = QKV + (size_t)(rowbase + q0) * 3072 + head * 128;
        const bf16* Kb = QKV + (size_t)rowbase * 3072 + 1024 + head * 128; const bf16* VTb = VT + (size_t)rowbase * 1024 + (size_t)(head * 128) * L;
        diff_unit2(lds, Qb, Kb, VTb, L, kt0, kt1, Qb, q0, slope2, -SB2, lam, a.in[30] + o * 128, 1.f - lambda_init);
    }
}
DI void vt_prep_x(unsigned char* lds, const bf16* KVX, bf16* VTX) {
    const int tid = otid(); bf16* T = (bf16*)lds;
    for (int item = obid(); item < 192; item += gridDim.x) {
        const int sh = item >> 2, kt = item & 3, seq = sh >> 2, head = sh & 3;
#pragma unroll
        for (int i = 0; i < 4; ++i) { const int c = tid + i * 512, r = c >> 5, cc = c & 31;
            *(u32x4*)(T + r * 264 + cc * 8) = *(const u32x4*)(KVX + (size_t)(seq * 256 + kt * 64 + r) * 2048 + 1024 + head * 256 + cc * 8); }
        __syncthreads();
        { const int e = tid >> 1, tq = (tid & 1) * 32; unsigned w[16];
#pragma unroll
          for (int i = 0; i < 16; ++i) w[i] = (unsigned)T[(tq + 2 * i) * 264 + e] | ((unsigned)T[(tq + 2 * i + 1) * 264 + e] << 16);
          bf16* dst = VTX + (size_t)(sh * 256 + e) * 256 + kt * 64 + tq;
#pragma unroll
          for (int i = 0; i < 2; ++i) { *(u32x4*)(dst + 16 * i) = (u32x4){w[8 * i], w[8 * i + 1], w[8 * i + 4], w[8 * i + 5]}; *(u32x4*)(dst + 16 * i + 8) = (u32x4){w[8 * i + 2], w[8 * i + 3], w[8 * i + 6], w[8 * i + 7]}; } }
        __syncthreads();
    }
}
DI void cross_unit2(unsigned char* lds, const bf16* Qb, const bf16* Kb, const bf16* VTb, bf16* Ob, float negSB2) {
    constexpr int KS = 264, VS = 40, KBUF = 32 * KS * 2  , VBUF = 256 * VS * 2  , VOFF = 2 * KBUF, NT = 8;
    const int tid = otid(), lane = tid & 63, wave = tid >> 6, l31 = lane & 31, hi = lane >> 5, qg = wave & 3, sel = wave >> 2;
    const int vrow0 = sel * 128;
    bf16x8 qf[16];
    { const bf16* qp = Qb + (size_t)(qg * 32 + l31) * 1024 + 8 * hi;
#pragma unroll
      for (int s = 0; s < 16; ++s) qf[s] = *(const bf16x8*)(qp + 16 * s); }
    f32x16 O[4];
#pragma unroll
    for (int nb = 0; nb < 4; ++nb) O[nb] = f32x16{};
    float lsum = 0.f;
    const int kr0 = tid >> 5, kc0 = (tid & 31) * 8, ve0 = tid >> 2, vc0 = (tid & 3) * 8;
    const bf16* kg = Kb + (size_t)kr0 * 2048 + kc0; const bf16* vg = VTb + (size_t)ve0 * 256 + vc0;
    u32x4 kreg[2], vreg[2];
#define X2_LOAD(t) do { kreg[0] = *(const u32x4*)(kg + (size_t)((t) * 32) * 2048); kreg[1] = *(const u32x4*)(kg + (size_t)((t) * 32 + 16) * 2048); \
                        vreg[0] = *(const u32x4*)(vg + (t) * 32); vreg[1] = *(const u32x4*)(vg + 128 * 256 + (t) * 32); } while (0)
#define X2_STORE(b) do { bf16* ks_ = (bf16*)(lds + (b) * KBUF); bf16* vs_ = (bf16*)(lds + VOFF + (b) * VBUF); \
                         *(u32x4*)(ks_ + kr0 * KS + kc0) = kreg[0]; *(u32x4*)(ks_ + (kr0 + 16) * KS + kc0) = kreg[1]; \
                         *(u32x4*)(vs_ + ve0 * VS + vc0) = vreg[0]; *(u32x4*)(vs_ + (ve0 + 128) * VS + vc0) = vreg[1]; } while (0)
    X2_LOAD(0); X2_STORE(0);
    __syncthreads();
#pragma unroll 1
    for (int t = 0; t < NT; ++t) {
        const int b = t & 1;
        if (t + 1 < NT) X2_LOAD(t + 1);
        const bf16* Ks = (const bf16*)(lds + b * KBUF); const bf16* Vt = (const bf16*)(lds + VOFF + b * VBUF);
        f32x16 st;
#pragma unroll
        for (int r = 0; r < 16; ++r) st[r] = negSB2;
#pragma unroll
        for (int s = 0; s < 16; ++s) { const bf16x8 av = *(const bf16x8*)(Ks + l31 * KS + 16 * s + 8 * hi); st = mfma32(av, qf[s], st); }
        float p[16];
#pragma unroll
        for (int r = 0; r < 16; ++r) { p[r] = __builtin_amdgcn_exp2f(st[r]); lsum += p[r]; }
        const bf16x8 pf0 = __builtin_bit_cast(bf16x8, pack8u(p)), pf1 = __builtin_bit_cast(bf16x8, pack8u(p + 8));
#pragma unroll
        for (int nb = 0; nb < 4; ++nb)
#pragma unroll
            for (int s2 = 0; s2 < 2; ++s2) { const u32x4 bw = *(const u32x4*)(Vt + (vrow0 + 32 * nb + l31) * VS + 16 * s2 + 8 * hi); O[nb] = mfma32(s2 ? pf1 : pf0, __builtin_bit_cast(bf16x8, bw), O[nb]); }
        if (t + 1 < NT) X2_STORE(b ^ 1);
        __syncthreads();
    }
#undef X2_LOAD
#undef X2_STORE
    lsum += __shfl_xor(lsum, 32);
    float invl[16];
#pragma unroll
    for (int r = 0; r < 16; ++r) invl[r] = 1.f / __shfl(lsum, crow(r, hi));
#pragma unroll
    for (int nb = 0; nb < 4; ++nb)
#pragma unroll
        for (int r = 0; r < 16; ++r) Ob[(size_t)(qg * 32 + crow(r, hi)) * 1024 + sel * 128 + 32 * nb + l31] = f2b(O[nb][r] * invl[r]);
}
DI void cross_attn_phase2(int layer, unsigned char* lds, bf16* qx, const bf16* kvx, const bf16* vtx) {
    const KArgs& a = *kargs();
    const int lane = otid() & 63;
    float gq = 0.f, gk = 0.f;
#pragma unroll
    for (int i = 0; i < 4; ++i) { gq = fmaxf(gq, fabsf(a.in[34][layer * 256 + lane + 64 * i])); gk = fmaxf(gk, fabsf(a.in[35][layer * 256 + lane + 64 * i])); }
    gq = wave_max(gq); gk = wave_max(gk);
    const float negSB2 = -(16.f * gq * gk * 1.02f + 0.5f) * LOG2E;
    for (int u = obid(); u < 1024; u += gridDim.x) {
        const int rb = u >> 2, head = u & 3, row0 = rb * 128; const int seq = row0 < 16384 ? (row0 >> 12) : 4 + ((row0 - 16384) >> 11);
        bf16* Qb = qx + (size_t)row0 * 1024 + head * 256; const bf16* Kb = kvx + (size_t)(seq * 256) * 2048 + head * 256; const bf16* VTb = vtx + (size_t)((seq * 4 + head) * 256) * 256;
        cross_unit2(lds, Qb, Kb, VTb, Qb, negSB2);
    }
}
#define LAS __attribute__((address_space(3)))
#define XB_TMO      128
#define XB_XCNT(j)  (256  + 64 * (j))
#define XB_XSUB(j)  (1280 + 64 * (j))
#define XB_XGEN(j)  (2304 + 64 * (j))
#define XB_TOP      3328
#define XB_TOPGEN   3392
#define XCD_BAR_WORDS 3456
#define XB_SPIN_CAP (1u << 18)

__device__ __forceinline__ unsigned xb_ld(unsigned* p)              { return __hip_atomic_load(p, __ATOMIC_RELAXED, __HIP_MEMORY_SCOPE_AGENT); }
__device__ __forceinline__ unsigned xb_add(unsigned* p, unsigned v) { return __hip_atomic_fetch_add(p, v, __ATOMIC_RELAXED, __HIP_MEMORY_SCOPE_AGENT); }
__device__ __forceinline__ unsigned xb_xcc_id() { return (unsigned)__builtin_amdgcn_s_getreg((3 << 11) | 20) & 0xFu; }
#define XB_SPIN(cond, bar) do { unsigned _sp = 0; while (cond) { __builtin_amdgcn_s_sleep(1); \
    if ((++_sp & 255u) == 0u) { if (xb_ld(&(bar)[XB_TMO])) break; if (_sp > XB_SPIN_CAP) { atomicAdd(&(bar)[XB_TMO], 1u); break; } } } } while (0)

struct XcdBarrier {
    unsigned* bar; unsigned x;
    volatile LAS unsigned* st;
};

__device__ __forceinline__ XcdBarrier xcd_barrier_post(unsigned* bar, volatile LAS unsigned* st) {
    XcdBarrier b; b.bar = bar; b.x = xb_xcc_id(); b.st = st;
    if (threadIdx.x == 0) (void)xb_add(&bar[XB_XCNT(b.x)], 1u);
    return b;
}
__device__ __forceinline__ void xcd_barrier_complete(unsigned* bar, unsigned x, unsigned& nloc, unsigned& nx) {
    const unsigned G = gridDim.x * gridDim.y * gridDim.z;
    unsigned sum, cnt, mine, sp = 0u;
    for (;;) {
        sum = 0u; cnt = 0u; mine = 0u;
#pragma unroll
        for (unsigned j = 0; j < 16; ++j) { const unsigned c = xb_ld(&bar[XB_XCNT(j)]); sum += c; cnt += (c > 0u) ? 1u : 0u; mine = (j == x) ? c : mine; }
        if (sum == G) break;
        __builtin_amdgcn_s_sleep(1);
        if ((++sp & 255u) == 0u) { if (xb_ld(&bar[XB_TMO])) break; if (sp > XB_SPIN_CAP) { atomicAdd(&bar[XB_TMO], 1u); break; } }
    }
    nloc = mine > 0u ? mine : 1u; nx = cnt > 0u ? cnt : 1u;
}

__device__ __forceinline__ void xcd_barrier(const XcdBarrier& b) {
    asm volatile("s_waitcnt vmcnt(0)" ::: "memory");
    __syncthreads();
    if (threadIdx.x == 0) {
        unsigned* bar = b.bar;
        __builtin_amdgcn_s_waitcnt(0);
        unsigned nloc = b.st[0], nx = b.st[1];
        if (nloc == 0u) { xcd_barrier_complete(bar, b.x, nloc, nx); b.st[0] = nloc; b.st[1] = nx; }
        const unsigned old = xb_add(&bar[XB_XSUB(b.x)], 1u);
        const unsigned gen = old / nloc;
        if (old + 1u == (gen + 1u) * nloc) {
            __builtin_amdgcn_fence(__ATOMIC_RELEASE, "agent");
            asm volatile("s_waitcnt vmcnt(0)" ::: "memory");
            const unsigned og = xb_add(&bar[XB_TOP], 1u);
            const unsigned tg = og / nx;
            if (og + 1u == (tg + 1u) * nx) xb_add(&bar[XB_TOPGEN], 1u);
            else XB_SPIN(xb_ld(&bar[XB_TOPGEN]) == tg, bar);
            __builtin_amdgcn_fence(__ATOMIC_ACQUIRE, "agent");
            xb_add(&bar[XB_XGEN(b.x)], 1u);
            asm volatile("s_waitcnt vmcnt(0)" ::: "memory");
        } else {
            XB_SPIN(xb_ld(&bar[XB_XGEN(b.x)]) == gen, bar);
            __builtin_amdgcn_fence(__ATOMIC_ACQUIRE, "agent");
            asm volatile("s_waitcnt vmcnt(0)" ::: "memory");
        }
    }
    __syncthreads();
}

__global__ void __launch_bounds__(512, 2) fwd_kernel(KArgs a) {
    extern __shared__ __attribute__((aligned(16))) unsigned char lds[];
    cg::grid_group grid = cg::this_grid();
    unsigned char* ws = a.ws; float* OUT = a.out;
    volatile LAS unsigned* MISC = (volatile LAS unsigned*)((LAS unsigned char*)lds + 131072 + 64);
    if (threadIdx.x < 2) MISC[threadIdx.x] = 0u;
    if (blockIdx.x == 0) for (int i = threadIdx.x; i < XCD_BAR_WORDS; i += 512) ((unsigned*)ws)[i] = 0u;
    __syncthreads();
    grid.sync();
    (void)xcd_barrier_post((unsigned*)ws, MISC);
#define GRID_BAR() do { XcdBarrier b_; b_.bar = (unsigned*)ws; b_.x = xb_xcc_id(); b_.st = (volatile LAS unsigned*)((LAS unsigned char*)lds + 131072 + 64); xcd_barrier(b_); } while (0)
    bf16* RB = (bf16*)(ws + WS_HN);
    bf16* HN = (bf16*)a.out; bf16* BIG = (bf16*)(ws + WS_BIG); bf16* MN = (bf16*)(ws + WS_MN);
    bf16* XBB = (bf16*)(ws + WS_XBB); float* RSQ = (float*)(ws + WS_ROWSQ);
    bf16* YF = HN; bf16* YB = HN + (size_t)MTOK * 512; bf16* KVB = (bf16*)(ws + WS_KV); float* DEC = (float*)(ws + WS_DEC); bf16* KVX = (bf16*)(ws + WS_KVX);
#pragma unroll 1
    for (int layer = 0; layer < 4; ++layer) {
        const bool even = !(layer & 1); const int hl = layer >> 1;
#pragma unroll 1
        for (int step = 0; step < 15; ++step) {
            bool sync = true;
            switch (step) {
            case 0:
              for (int rep_ = 0; rep_ < (PROBE == 6 ? 2 : 1); ++rep_) {
                convert_weights(layer, lds);
                if (layer == 0) prep_rows(kargs()->in[0], kargs()->in[1], RB, RSQ);
                norm_rows<false>(kargs()->in[2], kargs()->in[3], 1024, 3072, kargs()->in[6] + layer * 1024, MN, nullptr);
              }
                break;
            case 1: for (int rep_ = 0; rep_ < (PROBE == 1 ? 2 : 1); ++rep_) if (even) run_gemm<MTOK, 2304, 1024, 1024>(lds, RB, (const bf16*)(ws + W_IN), pg8::EpiB<0, true>{BIG, 2304, RSQ}); else run_gemm<MTOK, 3072, 1024, 1024>(lds, RB, (const bf16*)(ws + W_IN), pg8::EpiQKV{BIG, RSQ, kargs()->in[24] + hl * 64, kargs()->in[25] + hl * 64, 0.125f * LOG2E}); break;
            case 2:
                if (even) { for (int rep_ = 0; rep_ < (PROBE == 2 ? 2 : 1); ++rep_) { s5_phase(hl, lds, BIG, YF, YB); __syncthreads(); } for (int rep_ = 0; rep_ < (PROBE == 3 ? 2 : 1); ++rep_) gla_g1(hl, lds, BIG, KVB, DEC); }
                else vt_prep(lds, BIG, HN);
                break;
            case 3:
                if (even) { gla_g2(KVB, DEC); s5_combine(hl, BIG, YF, YB); }
                else diff_attn_phase2(hl, layer, lds, BIG, HN);
                break;
            case 4:
                if (even) { for (int rep_ = 0; rep_ < (PROBE == 3 ? 2 : 1); ++rep_) gla_g3(hl, lds, BIG, KVB, HN); run_gemm<MTOK, 512, 512, 2304>(lds, BIG, (const bf16*)(ws + W_GLU), pg8::EpiGlu{BIG, 2304, HN, 1024}); }
                else sync = false;
                break;
            case 5: if (even) run_gemm<MTOK, 1024, 1024, 1024>(lds, HN, (const bf16*)(ws + W_OUT), pg8::EpiRes3<false>{RB, RSQ + 1 * 524288, nullptr}); else run_gemm<MTOK, 1024, 1024, 3072>(lds, BIG, (const bf16*)(ws + W_OUT), pg8::EpiRes3<false>{RB, RSQ + 1 * 524288, nullptr}); break;
            case 6: sync = false; break;
            case 7: for (int rep_ = 0; rep_ < (PROBE == 1 ? 2 : 1); ++rep_) run_gemm<MTOK, 1024, 1024, 1024>(lds, RB, (const bf16*)(ws + W_XQ), pg8::EpiB<0, true>{BIG, 1024, RSQ + 1 * 524288}); sync = false; break;
            case 8: for (int rep_ = 0; rep_ < (PROBE == 1 ? 2 : 1); ++rep_) run_gemm<3072, 2048, 1024, 1024>(lds, MN, (const bf16*)(ws + W_XKV), pg8::EpiB<0>{KVX, 2048, nullptr}); break;
            case 9:
                segnorm(BIG, 1024, MTOK, 2, 256, kargs()->in[34] + layer * 256, 0.0625f * LOG2E, 2, kargs()->in[34] + layer * 256, 0.0625f * LOG2E);
                segnorm(KVX, 2048, 3072, 2, 256, kargs()->in[35] + layer * 256, 1.f, 2, kargs()->in[35] + layer * 256, 1.f);
                vt_prep_x(lds, KVX, (bf16*)(ws + WS_KVX + 16 * MiB));
                break;
            case 10: cross_attn_phase2(layer, lds, BIG, KVX, (const bf16*)(ws + WS_KVX + 16 * MiB)); break;
            case 11: run_gemm<MTOK, 1024, 1024, 1024>(lds, BIG, (const bf16*)(ws + W_XO), pg8::EpiRes3<false>{RB, RSQ + 2 * 524288, nullptr}); break;
            case 12: sync = false; break;
            case 13: for (int rep_ = 0; rep_ < (PROBE == 1 ? 2 : 1); ++rep_) run_gemm<MTOK, 4096, 1024, 1024>(lds, RB, (const bf16*)(ws + W_1), pg8::EpiB<1, true>{BIG, 4096, RSQ + 2 * 524288}); break;
            default: if (layer == 3) run_gemm<MTOK, 1024, 4096, 4096>(lds, BIG, (const bf16*)(ws + W_2), pg8::EpiRes3<true>{RB, nullptr, OUT});
                     else run_gemm<MTOK, 1024, 4096, 4096>(lds, BIG, (const bf16*)(ws + W_2), pg8::EpiRes3<false>{RB, RSQ, nullptr}); break;
            }
            if (sync) { GRID_BAR(); if (PROBE == 4) GRID_BAR(); }
        }
    }
}
extern "C" void kernel_launch(void* const* d_in, const int* in_sizes, int n_in, void* d_out, int out_size, void* d_ws, size_t ws_size, hipStream_t stream) {
    static int grid = 0;
    if (grid == 0) {
        if (n_in != 38 || out_size != MTOK * 1024 || ws_size < WS_END) { fprintf(stderr, "kernel_launch: unexpected shapes n_in %d out %d ws %zu (need %zu)\n", n_in, out_size, ws_size, (size_t)WS_END); grid = -1; return; }
        int dev = 0, cus = 0, per_cu = 0;
        hipGetDevice(&dev); hipDeviceGetAttribute(&cus, hipDeviceAttributeMultiprocessorCount, dev);
        if (hipFuncSetAttribute((const void*)fwd_kernel, hipFuncAttributeMaxDynamicSharedMemorySize, LDS_BYTES) != hipSuccess) { fprintf(stderr, "kernel_launch: hipFuncSetAttribute failed\n"); grid = -1; return; }
        if (hipOccupancyMaxActiveBlocksPerMultiprocessor(&per_cu, (const void*)fwd_kernel, 512, LDS_BYTES) != hipSuccess || per_cu < 1) { fprintf(stderr, "kernel_launch: occupancy query gave %d\n", per_cu); per_cu = 1; }
        (void)hipGetLastError();
        grid = cus * (per_cu > 1 ? 1 : per_cu);
        if (grid <= 0) grid = 256;
    }
    if (grid < 0) return;
    KArgs a{};
    for (int i = 0; i < 38; ++i) a.in[i] = (const float*)d_in[i];
    a.out = (float*)d_out; a.ws = (unsigned char*)d_ws;
    void* args[] = {&a};
    hipError_t e = hipLaunchCooperativeKernel((const void*)fwd_kernel, dim3(grid), dim3(512), args, LDS_BYTES, stream);
    if (e != hipSuccess) fprintf(stderr, "cooperative launch failed: %s (grid %d)\n", hipGetErrorString(e), grid);
}
```
